# Optimizing an MI355X kernel written in HIP

```python
import math
import jax, jax.numpy as jnp
from jax import lax
import numpy as np

D_MODEL = 1024
BATCH = 16
SEQ = 2048
DEPTH = 1
DEC_BATCH = 128
DEC_SEQ = 1
PAST_LEN = 16384
PAGE_SIZE = 128

N_META = 16
POOL_WIDTH = D_MODEL // 2
POOL_WINDOWS = (2, 4, 8, 16)
N_POOL_GROUPS = len(POOL_WINDOWS)
POOL_GROUP = POOL_WIDTH // N_POOL_GROUPS
POOL_STATE = max(POOL_WINDOWS) - 1
HEAD_DIM = 64
N_HEADS = (D_MODEL // 2) // HEAD_DIM
N_KV_HEADS = 2
GQA_GROUP = N_HEADS // N_KV_HEADS
ATTN_WIDTH = N_HEADS * HEAD_DIM
KV_WIDTH = N_KV_HEADS * HEAD_DIM
MIX_WIDTH = POOL_WIDTH + ATTN_WIDTH
IN_WIDTH = POOL_WIDTH + ATTN_WIDTH + 2 * KV_WIDTH
WINDOW = 128
BLOCK = 128
ROPE_DIM = HEAD_DIM // 4
ROPE_THETA = 500000.0
D_FF = ((8 * D_MODEL // 3 + 127) // 128) * 128
EPS = 1e-6
SCALE = HEAD_DIM ** -0.5
NEG_INF = -1e30

kernel_name = 'hymba_pool_swa_sink_macaron_step'


def _rmsnorm(x, g):
    xf = x.astype(jnp.float32)
    y = xf * lax.rsqrt(jnp.mean(jnp.square(xf), axis=-1, keepdims=True) + EPS)
    return (y * g.astype(jnp.float32)).astype(x.dtype)


def _half_ffn(x, norm_g, w_gate, w_up, w_down):
    h = _rmsnorm(x, norm_g)
    return x + 0.5 * ((jax.nn.silu(h @ w_gate) * (h @ w_up)) @ w_down)


def _rope_partial(x, pos):
    half = ROPE_DIM // 2
    inv_freq = jnp.exp(-math.log(ROPE_THETA) * jnp.arange(half, dtype=jnp.float32) * (2.0 / ROPE_DIM))
    ang = pos.astype(jnp.float32)[:, None] * inv_freq[None, :]
    cos = jnp.cos(ang)[:, None, :]
    sin = jnp.sin(ang)[:, None, :]
    xf = x.astype(jnp.float32)
    x1 = xf[..., :half]
    x2 = xf[..., half:ROPE_DIM]
    out = jnp.concatenate([x1 * cos - x2 * sin, x2 * cos + x1 * sin, xf[..., ROPE_DIM:]], axis=-1)
    return out.astype(x.dtype)


def _project(h, pos, w_in, q_norm, k_norm):
    B, T, _ = h.shape
    z = h @ w_in
    o1 = POOL_WIDTH
    o2 = o1 + ATTN_WIDTH
    o3 = o2 + KV_WIDTH
    u = z[..., :o1]
    q = z[..., o1:o2].reshape(B, T, N_HEADS, HEAD_DIM)
    k = z[..., o2:o3].reshape(B, T, N_KV_HEADS, HEAD_DIM)
    v = z[..., o3:].reshape(B, T, N_KV_HEADS, HEAD_DIM)
    q = _rope_partial(_rmsnorm(q, q_norm), pos)
    k = _rope_partial(_rmsnorm(k, k_norm), pos)
    return u, q, k, v


def _pool_mix(u_ext, pos_out, pool_w, pool_scale):
    n_out = pos_out.shape[0]
    uf = u_ext.astype(jnp.float32)
    cs = jnp.cumsum(uf, axis=1)
    outs = []
    for g, w in enumerate(POOL_WINDOWS):
        sl = slice(g * POOL_GROUP, (g + 1) * POOL_GROUP)
        cp = jnp.pad(cs[..., sl], ((0, 0), (w, 0), (0, 0)))
        wsum = cp[:, w:] - cp[:, :-w]
        cnt = jnp.minimum(pos_out + 1, w).astype(jnp.float32)[None, :, None]
        d = wsum[:, -n_out:] / cnt - uf[:, -n_out:, sl]
        outs.append(d @ pool_w[g].astype(jnp.float32))
    y = jnp.concatenate(outs, axis=-1) * pool_scale.astype(jnp.float32)
    return y.astype(u_ext.dtype)


def _sink_probs(s, mask, sink):
    s = jnp.where(mask, s, NEG_INF)
    m = jnp.maximum(jnp.max(s, axis=-1, keepdims=True), sink)
    p = jnp.exp(s - m)
    return p / (jnp.sum(p, axis=-1, keepdims=True) + jnp.exp(sink - m))


def _swa_prompt(q, k, v, sinks):
    B, T = q.shape[0], q.shape[1]
    pad_front = (BLOCK - N_META % BLOCK) % BLOCK
    pad_end = (-(T + pad_front)) % BLOCK
    L = T + pad_front + pad_end
    nb = L // BLOCK
    padt = lambda a: jnp.pad(a.astype(jnp.float32), ((0, 0), (pad_front, pad_end), (0, 0), (0, 0)))
    qb = padt(q).reshape(B, nb, BLOCK, N_KV_HEADS, GQA_GROUP, HEAD_DIM)
    kb = padt(k).reshape(B, nb, BLOCK, N_KV_HEADS, HEAD_DIM)
    vb = padt(v).reshape(B, nb, BLOCK, N_KV_HEADS, HEAD_DIM)
    prev = lambda a: jnp.concatenate([jnp.zeros_like(a[:, :1]), a[:, :-1]], axis=1)
    k_band = jnp.concatenate([prev(kb), kb], axis=2)
    v_band = jnp.concatenate([prev(vb), vb], axis=2)
    pos = (jnp.arange(L) - pad_front).reshape(nb, BLOCK)
    kpos = jnp.concatenate([pos - BLOCK, pos], axis=1)
    diff = pos[:, :, None] - kpos[:, None, :]
    mask = (diff >= 0) & (diff < WINDOW) & (kpos[:, None, :] >= 0)
    s = jnp.einsum('bnqhgd,bnkhd->bnhgqk', qb, k_band) * SCALE
    sink = sinks.astype(jnp.float32).reshape(N_KV_HEADS, GQA_GROUP)[:, :, None, None]
    p = _sink_probs(s, mask[None, :, None, None], sink)
    o = jnp.einsum('bnhgqk,bnkhd->bnqhgd', p, v_band).reshape(B, L, ATTN_WIDTH)
    return o[:, pad_front:pad_front + T].astype(q.dtype)


def _swa_sample(q, k_new, v_new, cache_k, cache_v, sinks):
    B, S = q.shape[0], q.shape[1]
    n_win = cache_k.shape[1]
    k_ext = jnp.concatenate([cache_k.astype(k_new.dtype), k_new], axis=1)
    v_ext = jnp.concatenate([cache_v.astype(v_new.dtype), v_new], axis=1)
    qpos = PAST_LEN + jnp.arange(S)
    kpos = PAST_LEN - n_win + jnp.arange(n_win + S)
    diff = qpos[:, None] - kpos[None, :]
    mask = (diff >= 0) & (diff < WINDOW)
    qg = q.astype(jnp.float32).reshape(B, S, N_KV_HEADS, GQA_GROUP, HEAD_DIM)
    s = jnp.einsum('bqhgd,bkhd->bhgqk', qg, k_ext.astype(jnp.float32)) * SCALE
    sink = sinks.astype(jnp.float32).reshape(N_KV_HEADS, GQA_GROUP)[:, :, None, None]
    p = _sink_probs(s, mask, sink)
    o = jnp.einsum('bhgqk,bkhd->bqhgd', p, v_ext.astype(jnp.float32)).reshape(B, S, ATTN_WIDTH)
    return o.astype(q.dtype), k_ext[:, -n_win:], v_ext[:, -n_win:]


def setup_inputs(seed: int = 0) -> dict:
    key = jax.random.key(seed)
    ks = jax.random.split(key, 24)
    nrm = lambda k, shape, scale: scale * jax.random.normal(k, shape, jnp.float32)
    gain = lambda k, shape: 1.0 + 0.05 * jax.random.normal(k, shape, jnp.float32)
    n_win = min(WINDOW, PAST_LEN)
    return {
        'x_prompt': nrm(ks[0], (BATCH, SEQ, D_MODEL), 1.0),
        'x_sample': nrm(ks[1], (DEC_BATCH, DEC_SEQ, D_MODEL), 1.0),
        'state_pool': nrm(ks[2], (DEPTH, DEC_BATCH, POOL_STATE, POOL_WIDTH), 1.0),
        'cache_k': nrm(ks[3], (DEPTH, DEC_BATCH, n_win, N_KV_HEADS, HEAD_DIM), 1.0),
        'cache_v': nrm(ks[4], (DEPTH, DEC_BATCH, n_win, N_KV_HEADS, HEAD_DIM), 1.0),
        'meta_tokens': nrm(ks[5], (N_META, D_MODEL), 1.0),
        'ffn1_norm': gain(ks[6], (DEPTH, D_MODEL)),
        'ffn1_w_gate': nrm(ks[7], (DEPTH, D_MODEL, D_FF), D_MODEL ** -0.5),
        'ffn1_w_up': nrm(ks[8], (DEPTH, D_MODEL, D_FF), D_MODEL ** -0.5),
        'ffn1_w_down': nrm(ks[9], (DEPTH, D_FF, D_MODEL), D_FF ** -0.5),
        'mix_norm': gain(ks[10], (DEPTH, D_MODEL)),
        'w_in': nrm(ks[11], (DEPTH, D_MODEL, IN_WIDTH), D_MODEL ** -0.5),
        'q_norm': gain(ks[12], (DEPTH, HEAD_DIM)),
        'k_norm': gain(ks[13], (DEPTH, HEAD_DIM)),
        'attn_sinks': nrm(ks[14], (DEPTH, N_HEADS), 1.0),
        'pool_w': nrm(ks[15], (DEPTH, N_POOL_GROUPS, POOL_GROUP, POOL_GROUP), POOL_GROUP ** -0.5),
        'pool_scale': gain(ks[16], (DEPTH, POOL_WIDTH)),
        'w_out': nrm(ks[17], (DEPTH, MIX_WIDTH, D_MODEL), MIX_WIDTH ** -0.5),
        'ffn2_norm': gain(ks[18], (DEPTH, D_MODEL)),
        'ffn2_w_gate': nrm(ks[19], (DEPTH, D_MODEL, D_FF), D_MODEL ** -0.5),
        'ffn2_w_up': nrm(ks[20], (DEPTH, D_MODEL, D_FF), D_MODEL ** -0.5),
        'ffn2_w_down': nrm(ks[21], (DEPTH, D_FF, D_MODEL), D_FF ** -0.5),
    }


def reference(x_prompt, x_sample, state_pool, cache_k, cache_v, meta_tokens,
              ffn1_norm, ffn1_w_gate, ffn1_w_up, ffn1_w_down,
              mix_norm, w_in, q_norm, k_norm, attn_sinks, pool_w, pool_scale, w_out,
              ffn2_norm, ffn2_w_gate, ffn2_w_up, ffn2_w_down):
    B = x_prompt.shape[0]
    S = x_sample.shape[1]
    meta = jnp.broadcast_to(meta_tokens.astype(x_prompt.dtype)[None], (B, N_META, D_MODEL))
    xp = jnp.concatenate([meta, x_prompt], axis=1)
    T = xp.shape[1]
    pos_p = jnp.arange(T)
    pos_s = PAST_LEN + jnp.arange(S)
    xs = x_sample
    pool_p, k_p, v_p, pool_s, k_s, v_s = [], [], [], [], [], []
    for l in range(DEPTH):
        xp = _half_ffn(xp, ffn1_norm[l], ffn1_w_gate[l], ffn1_w_up[l], ffn1_w_down[l])
        u, q, k, v = _project(_rmsnorm(xp, mix_norm[l]), pos_p, w_in[l], q_norm[l], k_norm[l])
        mixed = jnp.concatenate([_pool_mix(u, pos_p, pool_w[l], pool_scale[l]),
                                 _swa_prompt(q, k, v, attn_sinks[l])], axis=-1)
        xp = xp + mixed @ w_out[l]
        xp = _half_ffn(xp, ffn2_norm[l], ffn2_w_gate[l], ffn2_w_up[l], ffn2_w_down[l])
        pool_p.append(u[:, -POOL_STATE:])
        k_p.append(k[:, -WINDOW:])
        v_p.append(v[:, -WINDOW:])
        xs = _half_ffn(xs, ffn1_norm[l], ffn1_w_gate[l], ffn1_w_up[l], ffn1_w_down[l])
        us, qs, ks_, vs_ = _project(_rmsnorm(xs, mix_norm[l]), pos_s, w_in[l], q_norm[l], k_norm[l])
        u_ext = jnp.concatenate([state_pool[l].astype(us.dtype), us], axis=1)
        attn_s, k_new, v_new = _swa_sample(qs, ks_, vs_, cache_k[l], cache_v[l], attn_sinks[l])
        mixed_s = jnp.concatenate([_pool_mix(u_ext, pos_s, pool_w[l], pool_scale[l]), attn_s], axis=-1)
        xs = xs + mixed_s @ w_out[l]
        xs = _half_ffn(xs, ffn2_norm[l], ffn2_w_gate[l], ffn2_w_up[l], ffn2_w_down[l])
        pool_s.append(u_ext[:, -POOL_STATE:])
        k_s.append(k_new)
        v_s.append(v_new)
    y_prompt = xp[:, N_META:]
    y_sample = xs
    return (y_prompt, y_sample, jnp.stack(pool_p), jnp.stack(k_p), jnp.stack(v_p),
            jnp.stack(pool_s), jnp.stack(k_s), jnp.stack(v_s))
```

```cpp
#include <hip/hip_runtime.h>
#include <hip/hip_cooperative_groups.h>
#include <cstdio>
#include <cstdint>
#include <cmath>
namespace cg = cooperative_groups;
namespace pg8 {
#define PG8_LAS __attribute__((address_space(3)))
typedef unsigned short bf16_t;
typedef short bf16x8 __attribute__((ext_vector_type(8)));
typedef float f32x4 __attribute__((ext_vector_type(4)));
typedef unsigned u32x4 __attribute__((ext_vector_type(4)));
constexpr int BM = 256, BK = 64, HALF = 128, HTB = HALF * BK * 2  , STAGE_BYTES = 8 * HTB, NXCD = 8, WGM = 4;

__host__ __device__ __forceinline__ int lds_byte(int r, int c) { const int st = (r >> 4) * 2 + (c >> 5), rr = r & 15, cc = c & 31, ob = rr * 64 + cc * 2; return st * 1024 + (ob ^ (((ob >> 9) & 1) << 5)); }
__host__ __device__ __forceinline__ void stage_rc(int b, int& R, int& C) { const int st = b / 1024, sb = b % 1024, swz = sb ^ (((sb >> 9) & 1) << 5); R = (st >> 1) * 16 + swz / 64; C = (st & 1) * 32 + (swz % 64) / 2; }
__host__ __device__ __forceinline__ int perm32(int rho) { const int n = rho >> 4, i = rho & 15; return 8 * (i >> 2) + 4 * n + (i & 3); }

struct Unit { int pm, pn, ui; };
struct Gemm { const bf16_t* A; const bf16_t* Bt; int M, N, K; };

struct StaticOrder {
    int nM, nN, nwg, G, c;
    __host__ __device__ void init(int M, int N, int G_, int c_) { nM = M / BM; nN = N / BM; nwg = nM * nN; G = G_; c = c_; }
    __host__ __device__ bool next(int i, Unit& u) const {
        const long L = (long)i * G + c; if (L >= nwg) return false;
        int wgid = (int)L; { const int q = nwg / NXCD, r = nwg % NXCD, xcd = wgid % NXCD, off = wgid / NXCD; wgid = (xcd < r ? xcd * (q + 1) : r * (q + 1) + (xcd - r) * q) + off; }
        const int nig = WGM * nN, gid = wgid / nig, fm = gid * WGM, gsz = (nM - fm) < WGM ? (nM - fm) : WGM;
        u.pm = fm + ((wgid % nig) % gsz); u.pn = (wgid % nig) / gsz; u.ui = i; return true;
    }
    __device__ __forceinline__ void a_ready(const Unit&) const {}
    __device__ __forceinline__ void done(const Unit&) const {}
};

__device__ __forceinline__ unsigned cvt_pk_bf16(float lo, float hi) { unsigned r; asm volatile("v_cvt_pk_bf16_f32 %0, %1, %2" : "=v"(r) : "v"(lo), "v"(hi)); return r; }
typedef float f32x2 __attribute__((ext_vector_type(2)));
template <class Epi, class Sched, bool ALIGN_EPI, bool SP2, int KC, bool ATILED = false>
__device__ __forceinline__ void gemm_phase(PG8_LAS unsigned char* lds, const Gemm g, const Sched& S, const Epi& E) {
    const int tid = threadIdx.x, wid = __builtin_amdgcn_readfirstlane(tid >> 6), lane = tid & 63, wr = wid >> 2, wc = wid & 3, fr = lane & 15, fq = lane >> 4;
    constexpr int K = KC, nt = K / BK;
    unsigned voffA[2], voffB[2];
#pragma unroll
    for (int i = 0; i < 2; ++i) { int R, C; stage_rc(tid * 16 + i * 8192, R, C); const int Rb = Epi::PERM ? ((R & ~31) + perm32(R & 31)) : R;
        voffA[i] = (unsigned)(R * (ATILED ? BK : K) + C) * 2u; voffB[i] = (unsigned)(Rb * K + C) * 2u; }
    const size_t kstep = (size_t)(BK * 2);
    const size_t kstepA = ATILED ? (size_t)(BM * BK * 2) : kstep, hstepA = ATILED ? (size_t)(HALF * BK * 2) : (size_t)HALF * K * 2;
    const size_t hstep = (size_t)HALF * K * 2;
    const size_t tstep = 2 * hstep;
    const unsigned ldsw = (unsigned)wid * 1024u;
    const int aoff = lds_byte(wr * 64 + fr, fq * 8), boff = lds_byte(wc * 32 + fr, fq * 8);
#define PG8_SA(b, h) (((b) * 2 + (h)) * HTB)
#define PG8_SB(b, h) ((4 + (b) * 2 + (h)) * HTB)
#define PG8_STAGE(bufoff, gbase, voff) do { _Pragma("unroll") for (int _i = 0; _i < 2; ++_i) \
        __builtin_amdgcn_global_load_lds((const unsigned*)((const char*)(gbase) + (voff)[_i]), (PG8_LAS unsigned*)(lds + (bufoff) + ldsw + _i * 8192), 16, 0, 0); } while (0)
#define PG8_LDA(dst, b, h) do { _Pragma("unroll") for (int m = 0; m < 4; ++m) _Pragma("unroll") for (int k = 0; k < 2; ++k) dst[m][k] = *(const PG8_LAS bf16x8*)(lds + PG8_SA(b, h) + aoff + m * 2048 + k * 1024); } while (0)
#define PG8_LDB(dst, b, h) do { _Pragma("unroll") for (int n = 0; n < 2; ++n) _Pragma("unroll") for (int k = 0; k < 2; ++k) dst[n][k] = *(const PG8_LAS bf16x8*)(lds + PG8_SB(b, h) + boff + n * 2048 + k * 1024); } while (0)
#define PG8_MMA(ai, bj, At, Bt) do { __builtin_amdgcn_s_setprio(1); _Pragma("unroll") for (int m = 0; m < 4; ++m) _Pragma("unroll") for (int n = 0; n < 2; ++n) _Pragma("unroll") for (int k = 0; k < 2; ++k) \
        acc[ai][bj][m][n] = __builtin_amdgcn_mfma_f32_16x16x32_bf16(Bt[n][k], At[m][k], acc[ai][bj][m][n], 0, 0, 0); __builtin_amdgcn_s_setprio(0); } while (0)
#define PG8_WAIT_V(n) asm volatile("s_waitcnt vmcnt(" #n ")" ::: "memory")
#define PG8_WAIT_L(n) asm volatile("s_waitcnt lgkmcnt(" #n ")" ::: "memory")
#define PG8_BAR __builtin_amdgcn_s_barrier()
#define PG8_SCHED __builtin_amdgcn_sched_barrier(0)
    Unit cur, nxt; int ui = 0;
    if (!S.next(0, cur)) return;
    f32x4 acc[2][2][4][2];
#pragma unroll
    for (int a = 0; a < 2; ++a)
#pragma unroll
        for (int b = 0; b < 2; ++b)
#pragma unroll
            for (int m = 0; m < 4; ++m)
#pragma unroll
                for (int n = 0; n < 2; ++n) acc[a][b][m][n] = (f32x4){0.f, 0.f, 0.f, 0.f};
    bf16x8 At[4][2], B0[2][2], B1[2][2];
    const char* cA = (const char*)g.A + (size_t)cur.pm * tstep; const char* cB = (const char*)g.Bt + (size_t)cur.pn * tstep;
    S.a_ready(cur);
    if constexpr (SP2) {
        PG8_STAGE(PG8_SB(0, 0), cB, voffB); PG8_STAGE(PG8_SB(0, 1), cB + hstep, voffB); PG8_STAGE(PG8_SA(0, 0), cA, voffA); PG8_STAGE(PG8_SA(0, 1), cA + hstepA, voffA);
        if (wr == 1) PG8_BAR;
        PG8_WAIT_V(2); PG8_BAR;
        PG8_STAGE(PG8_SB(1, 0), cB + kstep, voffB); PG8_STAGE(PG8_SA(1, 0), cA + kstepA, voffA); PG8_STAGE(PG8_SB(1, 1), cB + hstep + kstep, voffB);
        PG8_WAIT_V(6); PG8_BAR;
    } else {
        PG8_STAGE(PG8_SB(0, 0), cB, voffB); PG8_STAGE(PG8_SA(0, 0), cA, voffA); PG8_STAGE(PG8_SB(0, 1), cB + hstep, voffB); PG8_STAGE(PG8_SA(0, 1), cA + hstepA, voffA);
        if (wr == 1) PG8_BAR;
        PG8_WAIT_V(4); PG8_BAR;
        PG8_STAGE(PG8_SB(1, 0), cB + kstep, voffB); PG8_STAGE(PG8_SA(1, 0), cA + kstepA, voffA); PG8_STAGE(PG8_SB(1, 1), cB + hstep + kstep, voffB);
        PG8_WAIT_V(6); PG8_BAR;
    }
    for (;;) {
        const bool has_next = S.next(ui + 1, nxt);
        const char* nA = has_next ? (const char*)g.A + (size_t)nxt.pm * tstep : cA; const char* nB = has_next ? (const char*)g.Bt + (size_t)nxt.pn * tstep : cB;
        for (int t = 0; t < nt; t += 2) {
            const bool last = (t == nt - 2);
            const char* a1 = cA + (size_t)(t + 1) * kstepA;
            const char* a2 = last ? nA : cA + (size_t)(t + 2) * kstepA; const char* b2 = last ? nB : cB + (size_t)(t + 2) * kstep;
            const char* a3 = a2 + kstepA; const char* b3 = b2 + kstep;
            if (last && has_next) S.a_ready(nxt);
            if constexpr (SP2) {
            PG8_LDB(B0, 0, 0); PG8_LDB(B1, 0, 1); PG8_SCHED; PG8_LDA(At, 0, 0); PG8_STAGE(PG8_SA(1, 1), a1 + hstepA, voffA);
            PG8_WAIT_V(8); PG8_WAIT_L(0); PG8_BAR; PG8_MMA(0, 0, At, B0); PG8_MMA(0, 1, At, B1); PG8_BAR; PG8_SCHED;
            PG8_LDA(At, 0, 1); PG8_STAGE(PG8_SB(0, 0), b2, voffB); PG8_STAGE(PG8_SB(0, 1), b2 + hstep, voffB); PG8_STAGE(PG8_SA(0, 0), a2, voffA);
            PG8_WAIT_V(8); PG8_WAIT_L(0); PG8_BAR; PG8_MMA(1, 0, At, B0); PG8_MMA(1, 1, At, B1); PG8_BAR; PG8_SCHED;
            PG8_LDB(B0, 1, 0); PG8_LDB(B1, 1, 1); PG8_SCHED; PG8_LDA(At, 1, 0); PG8_STAGE(PG8_SA(0, 1), a2 + hstepA, voffA);
            PG8_WAIT_V(8); PG8_WAIT_L(0); PG8_BAR; PG8_MMA(0, 0, At, B0); PG8_MMA(0, 1, At, B1); PG8_BAR; PG8_SCHED;
            PG8_LDA(At, 1, 1); PG8_STAGE(PG8_SB(1, 0), b3, voffB); PG8_STAGE(PG8_SB(1, 1), b3 + hstep, voffB); PG8_STAGE(PG8_SA(1, 0), a3, voffA);
            PG8_WAIT_V(8); PG8_WAIT_L(0); PG8_BAR; PG8_MMA(1, 0, At, B0); PG8_MMA(1, 1, At, B1); PG8_BAR; PG8_SCHED;
            } else {
            PG8_LDB(B0, 0, 0); PG8_SCHED; PG8_LDA(At, 0, 0); PG8_STAGE(PG8_SA(1, 1), a1 + hstepA, voffA);
            PG8_WAIT_L(8); PG8_BAR; PG8_WAIT_L(0); PG8_MMA(0, 0, At, B0); PG8_BAR; PG8_SCHED;
            PG8_LDB(B1, 0, 1); PG8_STAGE(PG8_SB(0, 0), b2, voffB);
            PG8_BAR; PG8_WAIT_L(0); PG8_MMA(0, 1, At, B1); PG8_BAR;
            PG8_LDA(At, 0, 1); PG8_STAGE(PG8_SA(0, 0), a2, voffA);
            PG8_BAR; PG8_WAIT_L(0); PG8_MMA(1, 0, At, B0); PG8_BAR; PG8_SCHED;
            PG8_STAGE(PG8_SB(0, 1), b2 + hstep, voffB);
            PG8_WAIT_V(6); PG8_BAR; PG8_MMA(1, 1, At, B1); PG8_BAR;
            PG8_LDB(B0, 1, 0); PG8_SCHED; PG8_LDA(At, 1, 0); PG8_STAGE(PG8_SA(0, 1), a2 + hstepA, voffA);
            PG8_WAIT_L(8); PG8_BAR; PG8_WAIT_L(0); PG8_MMA(0, 0, At, B0); PG8_BAR; PG8_SCHED;
            PG8_LDB(B1, 1, 1); PG8_STAGE(PG8_SB(1, 0), b3, voffB);
            PG8_BAR; PG8_WAIT_L(0); PG8_MMA(0, 1, At, B1); PG8_BAR;
            PG8_LDA(At, 1, 1); PG8_STAGE(PG8_SA(1, 0), a3, voffA);
            PG8_BAR; PG8_WAIT_L(0); PG8_MMA(1, 0, At, B0); PG8_BAR; PG8_SCHED;
            PG8_STAGE(PG8_SB(1, 1), b3 + hstep, voffB);
            PG8_WAIT_V(6); PG8_BAR; PG8_MMA(1, 1, At, B1); PG8_BAR;
            }
        }
        if constexpr (ALIGN_EPI) { if (wr == 0) PG8_BAR; }
        if constexpr (!Epi::AFTER_DRAIN) { E(acc, cur, wr, wc, fr, fq); S.done(cur); }
        if (!has_next) break;
#pragma unroll
        for (int a = 0; a < 2; ++a)
#pragma unroll
            for (int b = 0; b < 2; ++b)
#pragma unroll
                for (int m = 0; m < 4; ++m)
#pragma unroll
                    for (int n = 0; n < 2; ++n) acc[a][b][m][n] = (f32x4){0.f, 0.f, 0.f, 0.f};
        cur = nxt; cA = nA; cB = nB; ++ui;
        if constexpr (ALIGN_EPI) { if (wr == 1) PG8_BAR; }
    }
    PG8_WAIT_V(0);
    if constexpr (!ALIGN_EPI) { if (wr == 0) PG8_BAR; }
    PG8_BAR;
    if constexpr (Epi::AFTER_DRAIN) { E.fused(acc, cur, wr, wc, fr, fq, lds, wid, lane); S.done(cur); }
#undef PG8_SA
#undef PG8_SB
#undef PG8_STAGE
#undef PG8_LDA
#undef PG8_LDB
#undef PG8_MMA
#undef PG8_WAIT_V
#undef PG8_WAIT_L
#undef PG8_BAR
#undef PG8_SCHED
}
}

#ifndef MK_N_LAUNCHES
#define MK_N_LAUNCHES 1
#endif
constexpr int NWAVES = 8, NTHR = 512;
constexpr int DM = 1024, NB = 16, SEQ = 2048, NMETA = 16, TT = SEQ + NMETA, DB = 128;
constexpr int MAIN = NB * SEQ;
constexpr int TAIL0 = MAIN, NTAIL = 144;
constexpr int MPAD = 33024;
constexpr int DFF = 2816, NGU = 2 * DFF, NIN = 1280, PW = 512, NH = 8, HD = 64, KVW = 128;
constexpr int PASTLEN = 16384, NPOS = TT + 1;
constexpr float EPS = 1e-6f;
constexpr size_t O_Y = 0, O_YS = 33554432, O_PP = 33685504, O_KP = 33808384, O_VP = 34070528, O_PS = 34332672, O_KS = 35315712, O_VS = 37412864, O_END = 39510016;
constexpr size_t MiB = 1u << 20;
constexpr size_t WS_CTL = 0, WS_ROPE = 1 * MiB, WS_SS = 2 * MiB, WS_SST = 4 * MiB + 65536, WS_W1GU = 5 * MiB, WS_W1D = 16 * MiB, WS_WIN = 22 * MiB, WS_WOUT = 25 * MiB, WS_W2GU = 27 * MiB, WS_W2D = 38 * MiB,
                 WS_XB = 44 * MiB, WS_X = 109 * MiB, WS_ACT = 239 * MiB, WS_U = 239 * MiB, WS_Q = 272 * MiB, WS_K = 305 * MiB, WS_V = 314 * MiB, WS_MIX = 323 * MiB, WS_END = 418 * MiB;
static_assert(WS_SS + (size_t)MAIN * 16 * 4 <= WS_SST && WS_SST + 3 * NTAIL * 32 * 4 <= WS_W1GU && WS_XB + (size_t)MPAD * DM * 2 <= WS_X && WS_X + (size_t)MPAD * DM * 4 <= WS_ACT && WS_ACT + (size_t)MPAD * DFF * 2 <= WS_END, "ws map");
static_assert(WS_U + (size_t)MPAD * PW * 2 <= WS_Q && WS_Q + (size_t)MPAD * PW * 2 <= WS_K && WS_K + (size_t)MPAD * KVW * 2 <= WS_V && WS_V + (size_t)MPAD * KVW * 2 <= WS_MIX && WS_MIX + (size_t)MPAD * DM * 2 <= WS_END, "ws overlay");
constexpr int RING_BYTES = 131072, LDS_BYTES = 147456;

#define LAS __attribute__((address_space(3)))
typedef unsigned short bf16;
typedef unsigned v4u __attribute__((ext_vector_type(4)));
typedef unsigned v2u __attribute__((ext_vector_type(2)));
typedef float f32x4 __attribute__((ext_vector_type(4)));
typedef short bf16x8 __attribute__((ext_vector_type(8)));
typedef short s16x4 __attribute__((ext_vector_type(4)));
#define LDS_WAIT() asm volatile("s_waitcnt lgkmcnt(0)" ::: "memory")
#define RLX_AGENT __ATOMIC_RELAXED, __HIP_MEMORY_SCOPE_AGENT
#define XB_TMO      128
#define XB_XCNT(j)  (256  + 64 * (j))
#define XB_XSUB(j)  (1280 + 64 * (j))
#define XB_XGEN(j)  (2304 + 64 * (j))
#define XB_TOP      3328
#define XB_TOPGEN   3392
#define XCD_BAR_WORDS 3456
#define XB_SPIN_CAP (1u << 18)

__device__ __forceinline__ unsigned xb_ld(unsigned* p)              { return __hip_atomic_load(p, __ATOMIC_RELAXED, __HIP_MEMORY_SCOPE_AGENT); }
__device__ __forceinline__ unsigned xb_add(unsigned* p, unsigned v) { return __hip_atomic_fetch_add(p, v, __ATOMIC_RELAXED, __HIP_MEMORY_SCOPE_AGENT); }
__device__ __forceinline__ unsigned xb_xcc_id() { return (unsigned)__builtin_amdgcn_s_getreg((3 << 11) | 20) & 0xFu; }
#define XB_SPIN(cond, bar) do { unsigned _sp = 0; while (cond) { __builtin_amdgcn_s_sleep(1); \
    if ((++_sp & 255u) == 0u) { if (xb_ld(&(bar)[XB_TMO])) break; if (_sp > XB_SPIN_CAP) { atomicAdd(&(bar)[XB_TMO], 1u); break; } } } } while (0)

struct XcdBarrier {
    unsigned* bar; unsigned x;
    volatile LAS unsigned* st;
};

__device__ __forceinline__ XcdBarrier xcd_barrier_post(unsigned* bar, volatile LAS unsigned* st) {
    XcdBarrier b; b.bar = bar; b.x = xb_xcc_id(); b.st = st;
    if (threadIdx.x == 0) (void)xb_add(&bar[XB_XCNT(b.x)], 1u);
    return b;
}
__device__ __forceinline__ void xcd_barrier_complete(unsigned* bar, unsigned x, unsigned& nloc, unsigned& nx) {
    const unsigned G = gridDim.x * gridDim.y * gridDim.z;
    unsigned sum, cnt, mine, sp = 0u;
    for (;;) {
        sum = 0u; cnt = 0u; mine = 0u;
#pragma unroll
        for (unsigned j = 0; j < 16; ++j) { const unsigned c = xb_ld(&bar[XB_XCNT(j)]); sum += c; cnt += (c > 0u) ? 1u : 0u; mine = (j == x) ? c : mine; }
        if (sum == G) break;
        __builtin_amdgcn_s_sleep(1);
        if ((++sp & 255u) == 0u) { if (xb_ld(&bar[XB_TMO])) break; if (sp > XB_SPIN_CAP) { atomicAdd(&bar[XB_TMO], 1u); break; } }
    }
    nloc = mine > 0u ? mine : 1u; nx = cnt > 0u ? cnt : 1u;
}

__device__ __forceinline__ void xcd_barrier(const XcdBarrier& b) {
    asm volatile("s_waitcnt vmcnt(0)" ::: "memory");
    __syncthreads();
    if (threadIdx.x == 0) {
        unsigned* bar = b.bar;
        __builtin_amdgcn_s_waitcnt(0);
        unsigned nloc = b.st[0], nx = b.st[1];
        if (nloc == 0u) { xcd_barrier_complete(bar, b.x, nloc, nx); b.st[0] = nloc; b.st[1] = nx; }
        const unsigned old = xb_add(&bar[XB_XSUB(b.x)], 1u);
        const unsigned gen = old / nloc;
        if (old + 1u == (gen + 1u) * nloc) {
            __builtin_amdgcn_fence(__ATOMIC_RELEASE, "agent");
            asm volatile("s_waitcnt vmcnt(0)" ::: "memory");
            const unsigned og = xb_add(&bar[XB_TOP], 1u);
            const unsigned tg = og / nx;
            if (og + 1u == (tg + 1u) * nx) xb_add(&bar[XB_TOPGEN], 1u);
            else XB_SPIN(xb_ld(&bar[XB_TOPGEN]) == tg, bar);
            __builtin_amdgcn_fence(__ATOMIC_ACQUIRE, "agent");
            xb_add(&bar[XB_XGEN(b.x)], 1u);
            asm volatile("s_waitcnt vmcnt(0)" ::: "memory");
        } else {
            XB_SPIN(xb_ld(&bar[XB_XGEN(b.x)]) == gen, bar);
            __builtin_amdgcn_fence(__ATOMIC_ACQUIRE, "agent");
            asm volatile("s_waitcnt vmcnt(0)" ::: "memory");
        }
    }
    __syncthreads();
}


using pg8::cvt_pk_bf16;
typedef short v4i16_t __attribute__((ext_vector_type(4)));
__device__ __forceinline__ s16x4 vtr(const LAS unsigned char* p) { return __builtin_bit_cast(s16x4, __builtin_amdgcn_ds_read_tr16_b64_v4i16((LAS v4i16_t*)p)); }
__device__ __forceinline__ float bf2f(unsigned short h) { return __uint_as_float((unsigned)h << 16); }
__device__ __forceinline__ float row_rstd(const float* SS, int r) {
    const f32x4* p = (const f32x4*)(SS + (size_t)r * 16);
    const f32x4 a = p[0], b = p[1], c = p[2], d = p[3]; const f32x4 s = (a + b) + (c + d);
    return __builtin_amdgcn_rsqf(((s.x + s.y) + (s.z + s.w)) * (1.0f / DM) + EPS);
}
__device__ __forceinline__ float silu_mul(float g, float u) { return g * __builtin_amdgcn_rcpf(1.0f + __builtin_amdgcn_exp2f(-1.4426950408889634f * g)) * u; }

struct Args {
    const float* in[22]; float* out; unsigned char* ws; float invf[8]; int ph_lo, ph_hi;
};
typedef const __attribute__((address_space(4))) Args* KArgs;
__device__ __forceinline__ KArgs kargs_now() { KArgs ka = (KArgs)__builtin_amdgcn_kernarg_segment_ptr(); asm volatile("" : "+s"(ka)); return ka; }
struct EpiSwiGLU {
    static constexpr bool PERM = true, AFTER_DRAIN = false;
    const LAS float* rst;
    __device__ __forceinline__ void operator()(const f32x4 (&acc)[2][2][4][2], const pg8::Unit& u, int wr, int wc, int fr, int fq) const {
        const KArgs ka = kargs_now(); unsigned char* ws = ka->ws; bf16* O = (bf16*)(ws + WS_ACT); const LAS float* rt = rst + u.ui * 256 + wr * 64 + fr;
        const int row0 = u.pm * 256 + wr * 64 + fr, col0 = u.pn * 128 + wc * 32 + 8 * fq;
#pragma unroll
        for (int ai = 0; ai < 2; ++ai)
#pragma unroll
            for (int m = 0; m < 4; ++m) {
                const int r = row0 + ai * 128 + m * 16; const float rs = rt[ai * 128 + m * 16];
                const f32x4 g0 = acc[ai][0][m][0] * rs, g1 = acc[ai][0][m][1] * rs, u0 = acc[ai][1][m][0] * rs, u1 = acc[ai][1][m][1] * rs;
                v4u w; w.x = cvt_pk_bf16(silu_mul(g0[0], u0[0]), silu_mul(g0[1], u0[1])); w.y = cvt_pk_bf16(silu_mul(g0[2], u0[2]), silu_mul(g0[3], u0[3]));
                w.z = cvt_pk_bf16(silu_mul(g1[0], u1[0]), silu_mul(g1[1], u1[1])); w.w = cvt_pk_bf16(silu_mul(g1[2], u1[2]), silu_mul(g1[3], u1[3]));
                __builtin_nontemporal_store(w, (v4u*)(O + (size_t)(r >> 8) * (256 * DFF) + (size_t)(col0 >> 6) * (256 * 64) + (r & 255) * 64 + (col0 & 63)));
            }
    }
};
template <int MODE> struct EpiRes {
    static constexpr bool PERM = true, AFTER_DRAIN = false;
    __device__ __forceinline__ void operator()(const f32x4 (&acc)[2][2][4][2], const pg8::Unit& u, int wr, int wc, int fr, int fq) const {
        const KArgs ka = kargs_now(); unsigned char* ws = ka->ws; bf16* XB = (bf16*)(ws + WS_XB); float* SS = (float*)(ws + WS_SS); float* out = ka->out;
        constexpr float alpha = (MODE == 1) ? 1.0f : 0.5f;
        const int col0 = u.pn * 256 + wc * 32 + 8 * fq;
        v4u xin[2][4][2];
#pragma unroll
        for (int ai = 0; ai < 2; ++ai)
#pragma unroll
            for (int m = 0; m < 4; ++m) { const bf16* xrow = XB + (size_t)(u.pm * 256 + ai * 128 + wr * 64 + m * 16 + fr) * DM + col0;
#pragma unroll
                for (int bj = 0; bj < 2; ++bj) xin[ai][m][bj] = *(const v4u*)(xrow + bj * 128); }
#pragma unroll
        for (int ai = 0; ai < 2; ++ai)
#pragma unroll
            for (int m = 0; m < 4; ++m) {
                const int r = u.pm * 256 + ai * 128 + wr * 64 + m * 16 + fr;
                bf16* xrow = XB + (size_t)r * DM + col0; float* dst = out + O_Y + (size_t)r * DM + col0;
                float ss = 0.f;
#pragma unroll
                for (int bj = 0; bj < 2; ++bj) {
                    const v4u xi = xin[ai][m][bj]; f32x4 v0 = acc[ai][bj][m][0] * alpha, v1 = acc[ai][bj][m][1] * alpha;
                    v0[0] += __uint_as_float(xi.x << 16); v0[1] += __uint_as_float(xi.x & 0xffff0000u); v0[2] += __uint_as_float(xi.y << 16); v0[3] += __uint_as_float(xi.y & 0xffff0000u);
                    v1[0] += __uint_as_float(xi.z << 16); v1[1] += __uint_as_float(xi.z & 0xffff0000u); v1[2] += __uint_as_float(xi.w << 16); v1[3] += __uint_as_float(xi.w & 0xffff0000u);
                    if (MODE < 2) { v4u w; w.x = cvt_pk_bf16(v0[0], v0[1]); w.y = cvt_pk_bf16(v0[2], v0[3]); w.z = cvt_pk_bf16(v1[0], v1[1]); w.w = cvt_pk_bf16(v1[2], v1[3]); *(v4u*)(xrow + bj * 128) = w;
                        ss += ((v0[0] * v0[0] + v0[1] * v0[1]) + (v0[2] * v0[2] + v0[3] * v0[3])) + ((v1[0] * v1[0] + v1[1] * v1[1]) + (v1[2] * v1[2] + v1[3] * v1[3])); }
                    else { __builtin_nontemporal_store(v0, (f32x4*)(dst + bj * 128)); __builtin_nontemporal_store(v1, (f32x4*)(dst + bj * 128 + 4)); }
                }
                if (MODE < 2) { ss += __shfl_xor(ss, 16); ss += __shfl_xor(ss, 32); if (fq == 0) SS[(size_t)r * 16 + u.pn * 4 + wc] = ss; }
            }
    }
};
struct EpiIn {
    static constexpr bool PERM = true, AFTER_DRAIN = false;
    const LAS float* rst;
    __device__ __forceinline__ void operator()(const f32x4 (&acc)[2][2][4][2], const pg8::Unit& u, int wr, int wc, int fr, int fq) const {
        const KArgs ka = kargs_now(); unsigned char* ws = ka->ws; const LAS float* rt = rst + u.ui * 256 + wr * 64 + fr; bf16 *U = (bf16*)(ws + WS_U), *Q = (bf16*)(ws + WS_Q), *Kb = (bf16*)(ws + WS_K), *Vb = (bf16*)(ws + WS_V);
        const float* rope = (const float*)(ws + WS_ROPE); const float* qn = ka->in[12]; const float* kn = ka->in[13]; float* out = ka->out;
        const int row0 = u.pm * 256 + wr * 64 + fr;
        if (u.pn < 2) {
            const int col0 = u.pn * 256 + wc * 32 + 8 * fq;
#pragma unroll
            for (int ai = 0; ai < 2; ++ai)
#pragma unroll
                for (int m = 0; m < 4; ++m) {
                    const int r = row0 + ai * 128 + m * 16; const float rs = rt[ai * 128 + m * 16];
                    float* po = nullptr;
                    { const int b = r >> 11, t = (r & (SEQ - 1)) + NMETA; if (t >= TT - 15) po = out + O_PP + ((size_t)b * 15 + (t - (TT - 15))) * PW; }
#pragma unroll
                    for (int bj = 0; bj < 2; ++bj) {
                        const int c = col0 + bj * 128; const f32x4 v0 = acc[ai][bj][m][0] * rs, v1 = acc[ai][bj][m][1] * rs;
                        v4u w; w.x = cvt_pk_bf16(v0[0], v0[1]); w.y = cvt_pk_bf16(v0[2], v0[3]); w.z = cvt_pk_bf16(v1[0], v1[1]); w.w = cvt_pk_bf16(v1[2], v1[3]);
                        *(v4u*)(U + (size_t)r * PW + c) = w;
                        if (po) { *(f32x4*)(po + c) = v0; *(f32x4*)(po + c + 4) = v1; }
                    }
                }
        } else {
            int kind, hcol, ld; bf16* dst; const float* gain; size_t oprompt;
            if (u.pn < 4) { kind = 0; hcol = 64 * (4 * (u.pn - 2) + wc); ld = PW; dst = Q; gain = qn; oprompt = 0; }
            else if (wc < 2) { kind = 1; hcol = 64 * wc; ld = KVW; dst = Kb; gain = kn; oprompt = O_KP; }
            else { kind = 2; hcol = 64 * (wc - 2); ld = KVW; dst = Vb; gain = kn; oprompt = O_VP; }
            const int d0[2] = {fq == 0 ? 0 : 16 + 8 * (fq - 1), fq == 0 ? 8 : 40 + 8 * (fq - 1)};
            f32x4 gv[2][2];
#pragma unroll
            for (int bj = 0; bj < 2; ++bj)
#pragma unroll
                for (int n = 0; n < 2; ++n) gv[bj][n] = *(const f32x4*)(gain + d0[bj] + 4 * n);
            const bool rot = (kind < 2) && (fq == 0);
            f32x4 rcs[8][2], rsn[8][2];
            if (rot) { const float* rp = rope + (size_t)((row0 & (SEQ - 1)) + NMETA) * 16;
#pragma unroll
                for (int n = 0; n < 2; ++n) { rcs[0][n] = *(const f32x4*)(rp + 4 * n); rsn[0][n] = *(const f32x4*)(rp + 8 + 4 * n); } }
#pragma unroll
            for (int ai = 0; ai < 2; ++ai) {
#pragma unroll
                for (int m = 0; m < 4; ++m) {
                    if (rot && (ai * 4 + m) < 7) { const int r1 = row0 + ((ai * 4 + m + 1) >> 2) * 128 + ((ai * 4 + m + 1) & 3) * 16; const float* rp = rope + (size_t)((r1 & (SEQ - 1)) + NMETA) * 16;
#pragma unroll
                        for (int n = 0; n < 2; ++n) { rcs[ai * 4 + m + 1][n] = *(const f32x4*)(rp + 4 * n); rsn[ai * 4 + m + 1][n] = *(const f32x4*)(rp + 8 + 4 * n); } }
                    const int r = row0 + ai * 128 + m * 16; const float rs = rt[ai * 128 + m * 16];
                    f32x4 z[2][2];
#pragma unroll
                    for (int bj = 0; bj < 2; ++bj)
#pragma unroll
                        for (int n = 0; n < 2; ++n) z[bj][n] = acc[ai][bj][m][n] * rs;
                    const int b = r >> 11, t = (r & (SEQ - 1)) + NMETA;
                    if (kind < 2) {
                        float ss = 0.f;
#pragma unroll
                        for (int bj = 0; bj < 2; ++bj)
#pragma unroll
                            for (int n = 0; n < 2; ++n) ss += (z[bj][n][0] * z[bj][n][0] + z[bj][n][1] * z[bj][n][1]) + (z[bj][n][2] * z[bj][n][2] + z[bj][n][3] * z[bj][n][3]);
                        ss += __shfl_xor(ss, 16); ss += __shfl_xor(ss, 32);
                        const float inv = __builtin_amdgcn_rsqf(ss * (1.0f / HD) + EPS);
#pragma unroll
                        for (int bj = 0; bj < 2; ++bj)
#pragma unroll
                            for (int n = 0; n < 2; ++n) z[bj][n] = z[bj][n] * inv * gv[bj][n];
                        if (fq == 0) {
#pragma unroll
                            for (int n = 0; n < 2; ++n) { const f32x4 cs = rcs[ai * 4 + m][n], sn = rsn[ai * 4 + m][n]; const f32x4 x1 = z[0][n], x2 = z[1][n]; z[0][n] = x1 * cs - x2 * sn; z[1][n] = x2 * cs + x1 * sn; }
                        }
                    }
                    float* po = nullptr;
                    if (kind > 0 && t >= TT - 128) po = out + oprompt + ((size_t)b * 128 + (t - (TT - 128))) * KVW + hcol;
#pragma unroll
                    for (int bj = 0; bj < 2; ++bj) {
                        v4u w; w.x = cvt_pk_bf16(z[bj][0][0], z[bj][0][1]); w.y = cvt_pk_bf16(z[bj][0][2], z[bj][0][3]); w.z = cvt_pk_bf16(z[bj][1][0], z[bj][1][1]); w.w = cvt_pk_bf16(z[bj][1][2], z[bj][1][3]);
                        *(v4u*)(dst + (size_t)r * ld + hcol + d0[bj]) = w;
                        if (po) { *(f32x4*)(po + d0[bj]) = z[bj][0]; *(f32x4*)(po + d0[bj] + 4) = z[bj][1]; }
                    }
                }
            }
        }
    }
};

__device__ __forceinline__ float wave_sum(float v) {
#pragma unroll
    for (int o = 1; o < 64; o <<= 1) v += __shfl_xor(v, o);
    return v;
}
template <bool HG>
__device__ __forceinline__ void transpose_item(const float* W, int N, const float* gain, bf16* WT, int ldt, int nrow0, int k0, int sc, LAS float* scr, int lane) {
#pragma unroll
    for (int i = 0; i < 32; ++i) { const int kk = 2 * i + (lane >> 5); float v = W[(size_t)(k0 + kk) * N + sc]; if (HG) v *= gain[k0 + kk]; scr[kk * 33 + (lane & 31)] = v; }
    LDS_WAIT(); asm volatile("" ::: "memory");
    const int c = lane & 7;
#pragma unroll
    for (int j = 0; j < 4; ++j) { const int n = (lane >> 3) + 8 * j; const LAS float* s = scr + (8 * c) * 33 + n;
        v4u o; o.x = cvt_pk_bf16(s[0 * 33], s[1 * 33]); o.y = cvt_pk_bf16(s[2 * 33], s[3 * 33]); o.z = cvt_pk_bf16(s[4 * 33], s[5 * 33]); o.w = cvt_pk_bf16(s[6 * 33], s[7 * 33]);
        *(v4u*)(WT + (size_t)(nrow0 + n) * ldt + k0 + 8 * c) = o; }
    LDS_WAIT(); asm volatile("" ::: "memory");
}
__device__ __forceinline__ int win_src(int np) {
    const int pn = np >> 8; if (pn < 2) return np;
    const int bj = (np >> 7) & 1, wc = (np >> 5) & 3, j = np & 31, dm = (j < 8) ? 8 * bj + j : 16 + 24 * bj + (j - 8);
    if (pn < 4) return 512 + 64 * (4 * (pn - 2) + wc) + dm;
    return (wc < 2) ? 1024 + 64 * wc + dm : 1152 + 64 * (wc - 2) + dm;
}
__device__ __forceinline__ int win_row(int pn, int wc, int d) {
    const int bj = (d < 8) ? 0 : (d < 16) ? 1 : (d < 40) ? 0 : 1, j = (d < 8) ? d : (d < 16) ? d - 8 : (d < 40) ? d - 8 : d - 32;
    return 256 * pn + 128 * bj + 32 * wc + j;
}

constexpr int SLAB_P = 33, SLAB_F = NTAIL * SLAB_P, SLAB_B = SLAB_F * 4;
constexpr int T_SLABS = 0, T_R0 = 4 * SLAB_B, T_R1 = 5 * SLAB_B, T_RS = 6 * SLAB_B;
static_assert(T_RS + NTAIL * 4 <= RING_BYTES, "tail LDS");
template <int K, int MT = 9>
__device__ __forceinline__ void skinny_pass(const bf16* A, const bf16* bp0, const bf16* bp1, LAS unsigned char* lds, int roff, int tid, int wave, int lane, int m0 = 0) {
    constexpr int KW = K / 8, NS = KW / 32;
    const int c = lane & 15, g = lane >> 4;
    const bf16* ap = A + (size_t)(16 * m0 + c) * K + wave * KW + 8 * g;     const bf16* b0 = bp0 + wave * KW + 8 * g; const bf16* b1 = bp1 + wave * KW + 8 * g;
    f32x4 acc[MT][2];
#pragma unroll
    for (int m = 0; m < MT; ++m) { acc[m][0] = (f32x4){0.f, 0.f, 0.f, 0.f}; acc[m][1] = (f32x4){0.f, 0.f, 0.f, 0.f}; }
    bf16x8 af[MT], bf0, bf1;
#pragma unroll
    for (int m = 0; m < MT; ++m) af[m] = *(const bf16x8*)(ap + (size_t)(16 * m) * K);
    bf0 = *(const bf16x8*)(b0); bf1 = *(const bf16x8*)(b1);
#pragma unroll (MT <= 3 ? 4 : 1)
    for (int ks = 0; ks < NS; ++ks) {
        const int kn = (ks + 1 < NS) ? ks + 1 : ks;
        bf16x8 an[MT];
#pragma unroll
        for (int m = 0; m < MT; ++m) an[m] = *(const bf16x8*)(ap + (size_t)(16 * m) * K + 32 * kn);
        const bf16x8 bn0 = *(const bf16x8*)(b0 + 32 * kn), bn1 = *(const bf16x8*)(b1 + 32 * kn);
#pragma unroll
        for (int m = 0; m < MT; ++m) { acc[m][0] = __builtin_amdgcn_mfma_f32_16x16x32_bf16(af[m], bf0, acc[m][0], 0, 0, 0); acc[m][1] = __builtin_amdgcn_mfma_f32_16x16x32_bf16(af[m], bf1, acc[m][1], 0, 0, 0); }
#pragma unroll
        for (int m = 0; m < MT; ++m) af[m] = an[m];
        bf0 = bn0; bf1 = bn1;
    }
    LAS float* sl = (LAS float*)(lds + T_SLABS) + (wave & 3) * SLAB_F + (4 * g) * SLAB_P + c;
    if (wave >= 4) {
#pragma unroll
        for (int m = 0; m < MT; ++m)
#pragma unroll
            for (int n = 0; n < 2; ++n)
#pragma unroll
                for (int e = 0; e < 4; ++e) sl[(16 * m + e) * SLAB_P + 16 * n] = acc[m][n][e];
    }
    __syncthreads();
    if (wave < 4) {
#pragma unroll
        for (int m = 0; m < MT; ++m)
#pragma unroll
            for (int n = 0; n < 2; ++n)
#pragma unroll
                for (int e = 0; e < 4; ++e) { const float v = acc[m][n][e] + sl[(16 * m + e) * SLAB_P + 16 * n]; sl[(16 * m + e) * SLAB_P + 16 * n] = v; }
    }
    __syncthreads();
    { const LAS float* s0 = (const LAS float*)(lds + T_SLABS); LAS float* R = (LAS float*)(lds + roff);
      for (int idx = tid; idx < 16 * MT * 32; idx += NTHR) { const int o = (idx >> 5) * SLAB_P + (idx & 31); R[o] = (s0[o] + s0[SLAB_F + o]) + (s0[2 * SLAB_F + o] + s0[3 * SLAB_F + o]); } }
    __syncthreads();
}
__device__ __forceinline__ void tail_rstd(const float* sst, LAS unsigned char* lds, int tid) {
    if (tid < NTAIL) { const f32x4* p = (const f32x4*)(sst + (size_t)tid * 32); f32x4 s = p[0];
#pragma unroll
        for (int i = 1; i < 8; ++i) s += p[i];
        ((LAS float*)(lds + T_RS))[tid] = __builtin_amdgcn_rsqf(((s.x + s.y) + (s.z + s.w)) * (1.0f / DM) + EPS); }
    __syncthreads();
}

constexpr int I_G = 16 * 88, I_IN = 16 * 40, I_OA = 8 * 32, I_OP = 1024, NITEMS = 6 * I_G + I_IN + I_OA + I_OP;
__device__ __forceinline__ void conv_item(int r, KArgs ka, LAS float* scr, int lane) {
    unsigned char* ws = ka->ws;
    bf16 *W1GU = (bf16*)(ws + WS_W1GU), *W1D = (bf16*)(ws + WS_W1D), *WIN = (bf16*)(ws + WS_WIN), *WOUT = (bf16*)(ws + WS_WOUT), *W2GU = (bf16*)(ws + WS_W2GU), *W2D = (bf16*)(ws + WS_W2D);
    if (r < 6 * I_G) {
        const int f = r / (3 * I_G); r -= f * 3 * I_G; const int which = r / I_G; r -= which * I_G;
        const float* gain = ka->in[f ? 18 : 6];
        if (which < 2) { const int kb = r / 88, nb = r % 88, n0 = 32 * nb; const float* W = ka->in[(f ? 19 : 7) + which];
            transpose_item<true>(W, DFF, gain, f ? W2GU : W1GU, DM, 256 * (n0 >> 7) + (n0 & 127) + 128 * which, 64 * kb, n0 + (lane & 31), scr, lane); }
        else { const int kb = r / 32, nb = r % 32; const float* W = ka->in[f ? 21 : 9];
            transpose_item<false>(W, DM, nullptr, f ? W2D : W1D, DFF, 32 * nb, 64 * kb, 32 * nb + (lane & 31), scr, lane); }
        return;
    }
    r -= 6 * I_G;
    if (r < I_IN) { const int kb = r / 40, nb = r % 40; transpose_item<true>(ka->in[11], NIN, ka->in[10], WIN, DM, 32 * nb, 64 * kb, win_src(32 * nb + (lane & 31)), scr, lane); return; }
    r -= I_IN;
    if (r < I_OA) { const int kb = r / 32, nb = r % 32; transpose_item<false>(ka->in[17] + (size_t)PW * DM, DM, nullptr, WOUT + PW, DM, 32 * nb, 64 * kb, 32 * nb + (lane & 31), scr, lane); return; }
    r -= I_OA;
    {
        const int g = r >> 8, ib = (r >> 4) & 15, nb = r & 15, n = 64 * nb + lane;
        const float* pw = ka->in[15] + ((size_t)g * 128 + 8 * ib) * 128; const float* psc = ka->in[16] + 128 * g; const float* wo = ka->in[17] + (size_t)(128 * g) * DM + n;
        float a[8];
#pragma unroll
        for (int ii = 0; ii < 8; ++ii) a[ii] = 0.f;
#pragma unroll 32
        for (int j = 0; j < 128; ++j) { const float wv = wo[(size_t)j * DM] * psc[j];
#pragma unroll
            for (int ii = 0; ii < 8; ++ii) a[ii] += pw[ii * 128 + j] * wv; }
        v4u o; o.x = cvt_pk_bf16(a[0], a[1]); o.y = cvt_pk_bf16(a[2], a[3]); o.z = cvt_pk_bf16(a[4], a[5]); o.w = cvt_pk_bf16(a[6], a[7]);
        *(v4u*)(WOUT + (size_t)n * DM + 128 * g + 8 * ib) = o;
    }
}

__global__ void __launch_bounds__(NTHR, 2) hymba_fwd(Args args) {
    extern __shared__ __attribute__((aligned(16))) unsigned char lds_raw[];
    LAS unsigned char* lds = (LAS unsigned char*)lds_raw;
    const int tid = threadIdx.x, lane = tid & 63, wave = __builtin_amdgcn_readfirstlane(tid >> 6);
    const int G = gridDim.x, bx = blockIdx.x, vcu = (G % 8 == 0) ? (bx % 8) * (G / 8) + bx / 8 : bx;
    unsigned char* ws = args.ws;
    const float *x_prompt = args.in[0], *x_sample = args.in[1], *state_pool = args.in[2], *cache_k = args.in[3], *cache_v = args.in[4], *meta = args.in[5];
    float* out = args.out;
    float* SS = (float*)(ws + WS_SS); float* SST = (float*)(ws + WS_SST); float* ROPE = (float*)(ws + WS_ROPE);
    bf16 *W1GU = (bf16*)(ws + WS_W1GU), *W1D = (bf16*)(ws + WS_W1D), *WIN = (bf16*)(ws + WS_WIN), *WOUT = (bf16*)(ws + WS_WOUT), *W2GU = (bf16*)(ws + WS_W2GU), *W2D = (bf16*)(ws + WS_W2D);
    bf16 *XB = (bf16*)(ws + WS_XB), *ACT = (bf16*)(ws + WS_ACT), *Ub = (bf16*)(ws + WS_U), *Qb = (bf16*)(ws + WS_Q), *Kb = (bf16*)(ws + WS_K), *Vb = (bf16*)(ws + WS_V), *MIX = (bf16*)(ws + WS_MIX);
    const int lo = args.ph_lo, hi = args.ph_hi;
#define IN(k) (lo <= (k) && (k) < hi)
#define SEAM(k) do { if (IN(k) && IN((k) + 1)) { xcd_barrier(xbar); } } while (0)
    volatile LAS unsigned* xst = (volatile LAS unsigned*)(lds + RING_BYTES + 256);
    if (tid == 0) { xst[0] = 0u; xst[1] = 0u; }
    __syncthreads();
    XcdBarrier xbar; xbar.bar = (unsigned*)(ws + WS_CTL) + 4096; xbar.x = 0; xbar.st = nullptr;
    if (hi - lo > 1) xbar = xcd_barrier_post((unsigned*)(ws + WS_CTL) + 4096, xst);
    if (hi > 64) cg::this_grid().sync();

    LAS float* RST = (LAS float*)(lds + RING_BYTES + 1024);
#define BUILD_RST(S_) do { const int nU_ = ((S_).nwg - (S_).c + (S_).G - 1) / (S_).G, ntab_ = nU_ * 256; \
        for (int base_ = 0; base_ < ntab_; base_ += 4 * NTHR) { f32x4 p_[4][4]; \
            _Pragma("unroll") for (int e_ = 0; e_ < 4; ++e_) { int idx_ = base_ + tid + NTHR * e_; idx_ = idx_ < ntab_ ? idx_ : ntab_ - 1; pg8::Unit uu_; (S_).next(idx_ >> 8, uu_); \
                const f32x4* q_ = (const f32x4*)(SS + ((size_t)uu_.pm * 256 + (idx_ & 255)) * 16); p_[e_][0] = q_[0]; p_[e_][1] = q_[1]; p_[e_][2] = q_[2]; p_[e_][3] = q_[3]; } \
            _Pragma("unroll") for (int e_ = 0; e_ < 4; ++e_) { const int idx_ = base_ + tid + NTHR * e_; const f32x4 s_ = (p_[e_][0] + p_[e_][1]) + (p_[e_][2] + p_[e_][3]); \
                if (idx_ < ntab_) RST[idx_] = __builtin_amdgcn_rsqf(((s_.x + s_.y) + (s_.z + s_.w)) * (1.0f / DM) + EPS); } } \
        __syncthreads(); } while (0)
#define TAIL_SWIGLU(WGU, sst) do { tail_rstd((sst), lds, tid); \
        for (int su = bx; su < DFF / 16; su += G) { const int n0 = 16 * su, gr = 256 * (n0 >> 7) + (n0 & 127) + (lane & 15); \
            skinny_pass<DM>(XB + (size_t)TAIL0 * DM, (WGU) + (size_t)gr * DM, (WGU) + (size_t)(gr + 128) * DM, lds, T_R0, tid, wave, lane); \
            const LAS float* R = (const LAS float*)(lds + T_R0); const LAS float* RS = (const LAS float*)(lds + T_RS); \
            for (int idx = tid; idx < NTAIL * 16; idx += NTHR) { const int row = idx >> 4, col = idx & 15; const float rs = RS[row]; \
                ACT[(size_t)(TAIL0 + row) * DFF + n0 + col] = (bf16)(cvt_pk_bf16(silu_mul(R[row * SLAB_P + col] * rs, R[row * SLAB_P + 16 + col] * rs), 0.f) & 0xffffu); } \
            __syncthreads(); } } while (0)
#define TAIL_RES(MODE, KK, Aten, WT, sst_out) do { \
        for (int su = bx; su < 3 * (DM / 32); su += G) { const int cb = su / 3, mg = su - 3 * cb, n0 = 32 * cb, m0 = 3 * mg;     \
            skinny_pass<KK, 3>((Aten) + (size_t)TAIL0 * (KK), (WT) + (size_t)(n0 + (lane & 15)) * (KK), (WT) + (size_t)(n0 + 16 + (lane & 15)) * (KK), lds, T_R0, tid, wave, lane, m0); \
            const LAS float* R = (const LAS float*)(lds + T_R0); \
            for (int idx = tid; idx < 48 * 32; idx += NTHR) { const int rrel = idx >> 5, row = 16 * m0 + rrel, col = idx & 31; const size_t xo = (size_t)(TAIL0 + row) * DM + n0 + col; \
                const float v = bf2f(XB[xo]) + (((MODE) == 1) ? 1.0f : 0.5f) * R[rrel * SLAB_P + col]; \
                if ((MODE) < 2) { XB[xo] = (bf16)(cvt_pk_bf16(v, 0.f) & 0xffffu); float ss = v * v; ss += __shfl_xor(ss, 1); ss += __shfl_xor(ss, 2); ss += __shfl_xor(ss, 4); ss += __shfl_xor(ss, 8); ss += __shfl_xor(ss, 16); \
                    if (col == 0) (sst_out)[(size_t)row * 32 + cb] = ss; } \
                else if (row >= NMETA) out[O_YS + (size_t)(row - NMETA) * DM + n0 + col] = v; } \
            __syncthreads(); } } while (0)

    if (IN(0)) {
        LAS float* scr = (LAS float*)(lds + wave * 16384);
        const int gw = vcu * NWAVES + wave, NGW = G * NWAVES;
        { const KArgs ka = (KArgs)__builtin_amdgcn_kernarg_segment_ptr();
          for (int it = gw; it < 3 * I_G + I_IN; it += NGW) conv_item(it < 3 * I_G ? it : it + 3 * I_G, ka, scr, lane); }
        for (int r4 = gw; r4 < (MAIN + NTAIL) / 4; r4 += NGW) {
            f32x4 v[4][4];
#pragma unroll
            for (int rr = 0; rr < 4; ++rr) { const int r = 4 * r4 + rr; const float* src = (r < MAIN) ? x_prompt + (size_t)r * DM : (r < MAIN + NMETA) ? meta + (size_t)(r - MAIN) * DM : x_sample + (size_t)(r - MAIN - NMETA) * DM;
#pragma unroll
                for (int j = 0; j < 4; ++j) v[rr][j] = ((const f32x4*)src)[lane + 64 * j]; }
#pragma unroll
            for (int rr = 0; rr < 4; ++rr) { const int r = 4 * r4 + rr; float s = 0.f;
#pragma unroll
                for (int j = 0; j < 4; ++j) s += (v[rr][j].x * v[rr][j].x + v[rr][j].y * v[rr][j].y) + (v[rr][j].z * v[rr][j].z + v[rr][j].w * v[rr][j].w);
                s = wave_sum(s);
#pragma unroll
                for (int j = 0; j < 4; ++j) { v2u w; w.x = cvt_pk_bf16(v[rr][j].x, v[rr][j].y); w.y = cvt_pk_bf16(v[rr][j].z, v[rr][j].w); ((v2u*)(XB + (size_t)r * DM))[lane + 64 * j] = w; }
                if (r < MAIN) { if (lane < 16) SS[(size_t)r * 16 + lane] = (lane == 0) ? s : 0.f; } else if (lane < 32) SST[(size_t)(r - MAIN) * 32 + lane] = (lane == 0) ? s : 0.f; }
        }
        const int gt = vcu * NTHR + tid, NGT = G * NTHR;
        for (int i = gt; i < NPOS * 8; i += NGT) {
            const int p = i >> 3, f = i & 7; const float pos = (p < TT) ? (float)p : (float)PASTLEN; const float ang = pos * args.invf[f];
            const double xd = (double)ang, nn = __builtin_rint(xd * 0.15915494309189535), rr = __builtin_fma(-nn, 6.283185307179586, xd), r2 = rr * rr;
            double c = 1.0, s = rr, tc = 1.0, ts = rr;
#pragma unroll
            for (int k = 1; k <= 15; ++k) { tc *= -r2 * (1.0 / (double)((2 * k - 1) * (2 * k))); c += tc; ts *= -r2 * (1.0 / (double)((2 * k) * (2 * k + 1))); s += ts; }
            ROPE[(size_t)p * 16 + f] = (float)c; ROPE[(size_t)p * 16 + 8 + f] = (float)s;
        }
    }
    SEAM(0);
    if (IN(1)) { TAIL_SWIGLU(W1GU, SST);
        { pg8::Gemm g{XB, W1GU, MAIN, NGU, DM}; pg8::StaticOrder S; S.init(MAIN, NGU, G, bx); BUILD_RST(S); EpiSwiGLU E{RST};
        pg8::gemm_phase<EpiSwiGLU, pg8::StaticOrder, true, true, DM>(lds, g, S, E); }  }
    SEAM(1);
    if (IN(2)) { TAIL_RES(0, DFF, ACT, W1D, SST + NTAIL * 32);
        { pg8::Gemm g{ACT, W1D, MAIN, DM, DFF}; pg8::StaticOrder S; S.init(MAIN, DM, G, bx); EpiRes<0> E{};
        pg8::gemm_phase<EpiRes<0>, pg8::StaticOrder, true, true, DFF, true>(lds, g, S, E); }  }
    SEAM(2);
    if (IN(3)) {
        if (bx >= G / 2) {
            LAS float* scr = (LAS float*)(lds + wave * 16384); const int hw = (bx - G / 2) * NWAVES + wave, NHW = (G - G / 2) * NWAVES;
            const KArgs ka = (KArgs)__builtin_amdgcn_kernarg_segment_ptr();
            for (int it = hw; it < 3 * I_G + I_OA + I_OP; it += NHW) conv_item(it < 3 * I_G ? it + 3 * I_G : it + 3 * I_G + I_IN, ka, scr, lane);
            const int ht = (bx - G / 2) * NTHR + tid, NHT = (G - G / 2) * NTHR;
            for (int i = ht; i < DB * 14 * (PW / 4); i += NHT) { const int q = i / (14 * (PW / 4)), rem = i - q * (14 * (PW / 4)); ((f32x4*)(out + O_PS))[(size_t)q * 15 * (PW / 4) + rem] = ((const f32x4*)state_pool)[(size_t)q * 15 * (PW / 4) + (PW / 4) + rem]; }
            for (int i0 = ht; i0 < DB * 127 * (KVW / 4); i0 += 4 * NHT) { f32x4 kk[4], vv[4]; size_t dd[4];
#pragma unroll
                for (int u = 0; u < 4; ++u) { int i = i0 + u * NHT; i = i < DB * 127 * (KVW / 4) ? i : DB * 127 * (KVW / 4) - 1; const int q = i / (127 * (KVW / 4)), rem = i - q * (127 * (KVW / 4)); dd[u] = (size_t)q * 128 * (KVW / 4) + rem;
                    kk[u] = ((const f32x4*)cache_k)[dd[u] + (KVW / 4)]; vv[u] = ((const f32x4*)cache_v)[dd[u] + (KVW / 4)]; }
#pragma unroll
                for (int u = 0; u < 4; ++u) { ((f32x4*)(out + O_KS))[dd[u]] = kk[u]; ((f32x4*)(out + O_VS))[dd[u]] = vv[u]; } }
            __syncthreads();
        }
        tail_rstd(SST + NTAIL * 32, lds, tid);
        for (int s3 = (bx >= G / 2) ? bx - G / 2 : 60; s3 < 60; s3 += G / 2) { const int su = s3 / 3, m0 = 3 * (s3 - 3 * su);
            const int kind = (su < 8) ? 3 : (su < 16) ? 0 : (su < 18) ? 1 : 2;
            const int hh = (kind == 3) ? su : (kind == 0) ? su - 8 : (kind == 1) ? su - 16 : su - 18;
            const int pn = (kind == 3) ? (hh >> 2) : (kind == 0) ? 2 + (hh >> 2) : 4, wc = (kind == 3) ? 0 : (kind == 0) ? (hh & 3) : (kind == 1) ? hh : 2 + hh;
#pragma unroll
            for (int p = 0; p < 2; ++p) { const int d0 = 32 * p + (lane & 15);
                const int r0 = (kind == 3) ? 64 * hh + d0 : win_row(pn, wc, d0), r1 = (kind == 3) ? 64 * hh + d0 + 16 : win_row(pn, wc, d0 + 16);
                skinny_pass<DM, 3>(XB + (size_t)TAIL0 * DM, WIN + (size_t)r0 * DM, WIN + (size_t)r1 * DM, lds, p ? T_R1 : T_R0, tid, wave, lane, m0); }
            const LAS float* RS = (const LAS float*)(lds + T_RS); const int d = lane; const LAS float* R = (const LAS float*)(lds + ((d < 32) ? T_R0 : T_R1)) + (d & 31);
            const float gain = (kind == 0) ? args.in[12][d] : (kind == 1) ? args.in[13][d] : 1.0f;
            for (int rrel = wave; rrel < 48; rrel += NWAVES) { const int row = 16 * m0 + rrel;
                float v = R[rrel * SLAB_P] * RS[row]; const size_t tr = (size_t)TAIL0 + row;
                if (kind == 3) { Ub[tr * PW + 64 * hh + d] = (bf16)(cvt_pk_bf16(v, 0.f) & 0xffffu); if (row >= NMETA) out[O_PS + ((size_t)(row - NMETA) * 15 + 14) * PW + 64 * hh + d] = v; }
                else {
                    if (kind < 2) { const float ssq = wave_sum(v * v); v = v * __builtin_amdgcn_rsqf(ssq * (1.0f / HD) + EPS) * gain;
                        const float pr = __shfl_xor(v, 8); const float* rp = ROPE + (size_t)((row < NMETA) ? row : TT) * 16 + (d & 7); const float cs = rp[0], sn = rp[8];
                        if (d < 8) v = v * cs - pr * sn; else if (d < 16) v = v * cs + pr * sn; }
                    if (kind == 0) Qb[tr * PW + 64 * hh + d] = (bf16)(cvt_pk_bf16(v, 0.f) & 0xffffu);
                    else { bf16* dstp = (kind == 1) ? Kb : Vb; dstp[tr * KVW + 64 * hh + d] = (bf16)(cvt_pk_bf16(v, 0.f) & 0xffffu);
                        if (row >= NMETA) out[((kind == 1) ? O_KS : O_VS) + ((size_t)(row - NMETA) * 128 + 127) * KVW + 64 * hh + d] = v; }
                }
            }
            __syncthreads();
        }
        { pg8::Gemm g{XB, WIN, MAIN, NIN, DM}; pg8::StaticOrder S; S.init(MAIN, NIN, G, bx); BUILD_RST(S); EpiIn E{RST};
        pg8::gemm_phase<EpiIn, pg8::StaticOrder, true, true, DM>(lds, g, S, E); } }
    SEAM(3);
    if (IN(4)) {
        constexpr int KPITCH = 144, KROWS = 192, KS_BYTES = 2 * KROWS * KPITCH, VS_OFF = KS_BYTES, PB_OFF = 2 * KS_BYTES;
        static_assert(PB_OFF <= RING_BYTES, "attention LDS");
        const float* sinks = args.in[14];
        constexpr int NPU = NB * 32;
        for (int ui0 = vcu; ui0 < NPU; ui0 += G) {
            const int ui = (G == 256) ? (((2 * (bx & 7) + (ui0 >> 8)) << 5) + (bx >> 3)) : ui0;
            const int b = ui >> 5, blk = ui & 31, t0 = 64 * blk + NMETA; const size_t rb = (size_t)b * SEQ;
            v4u kreg[6], vreg[6];
#pragma unroll
            for (int it = 0; it < 6; ++it) { const int ch = tid + it * NTHR, kk = ch >> 4, c16 = ch & 15; int p = t0 - 128 + kk; p = p < 0 ? 0 : p; const size_t row = (p >= NMETA) ? rb + (p - NMETA) : (size_t)TAIL0 + p;
                kreg[it] = *(const v4u*)(Kb + row * KVW + c16 * 8); vreg[it] = *(const v4u*)(Vb + row * KVW + c16 * 8); }
            unsigned xr[48];
            const int cp = tid & 255, rh = tid >> 8;
#pragma unroll
            for (int ii = 0; ii < 48; ++ii) { const int p = t0 + 32 * rh - 16 + ii; const size_t row = (p >= NMETA) ? rb + (p - NMETA) : (size_t)TAIL0 + p; xr[ii] = *(const unsigned*)(Ub + row * PW + 2 * cp); }
            const int h = wave, kvh = h >> 2, q = lane & 15, g = lane >> 4;
            bf16x8 qf[4][2];
#pragma unroll
            for (int j = 0; j < 4; ++j) { const bf16* qp = Qb + (rb + (t0 - NMETA) + 16 * j + q) * PW + 64 * h + 8 * g; qf[j][0] = *(const bf16x8*)(qp); qf[j][1] = *(const bf16x8*)(qp + 32); }
            { float xa[48], xb[48];
#pragma unroll
              for (int ii = 0; ii < 48; ++ii) { xa[ii] = __uint_as_float(xr[ii] << 16); xb[ii] = __uint_as_float(xr[ii] & 0xffff0000u); }
              bf16* mp = MIX + (rb + (t0 - NMETA) + 32 * rh) * DM + 2 * cp; const int wsel = cp >> 6;
#define POOL_W(W) { float Sa = 0.f, Sb = 0.f; _Pragma("unroll") for (int i = 16 - (W); i < 16; ++i) { Sa += xa[i]; Sb += xb[i]; } \
                _Pragma("unroll") for (int tt = 0; tt < 32; ++tt) { Sa += xa[16 + tt] - xa[16 + tt - (W)]; Sb += xb[16 + tt] - xb[16 + tt - (W)]; \
                    *(unsigned*)(mp + (size_t)tt * DM) = cvt_pk_bf16(Sa * (1.0f / (float)(W)) - xa[16 + tt], Sb * (1.0f / (float)(W)) - xb[16 + tt]); } }
              if (wsel == 0) POOL_W(2) else if (wsel == 1) POOL_W(4) else if (wsel == 2) POOL_W(8) else POOL_W(16)
#undef POOL_W
            }
#pragma unroll
            for (int it = 0; it < 6; ++it) { const int ch = tid + it * NTHR, kk = ch >> 4, c16 = ch & 15, kv = c16 >> 3, c8 = c16 & 7; const bool ok = (t0 - 128 + kk) >= 0;
                const v4u z4 = (v4u){0u, 0u, 0u, 0u}; const int off = (kv * KROWS + kk) * KPITCH + c8 * 16;
                *(LAS v4u*)(lds + off) = ok ? kreg[it] : z4; *(LAS v4u*)(lds + VS_OFF + off) = ok ? vreg[it] : z4; }
            __syncthreads();
            { const float sink = sinks[h] * 1.4426950408889634f;
              const LAS unsigned char* ksb = lds + (kvh * KROWS) * KPITCH; const LAS unsigned char* vsb = lds + VS_OFF + (kvh * KROWS) * KPITCH + (4 * g + ((lane >> 2) & 3)) * KPITCH + (lane & 3) * 8;
#pragma unroll
              for (int j = 0; j < 4; ++j) {
                  const int tq0 = t0 + 16 * j;
                  f32x4 s[9];
#pragma unroll
                  for (int kt = 0; kt < 9; ++kt) { const LAS unsigned char* kp = ksb + (16 * (j + kt) + q) * KPITCH + 16 * g;
                      const bf16x8 k0 = *(const LAS bf16x8*)(kp), k1 = *(const LAS bf16x8*)(kp + 64);
                      f32x4 a = (f32x4){0.f, 0.f, 0.f, 0.f}; a = __builtin_amdgcn_mfma_f32_16x16x32_bf16(k0, qf[j][0], a, 0, 0, 0); a = __builtin_amdgcn_mfma_f32_16x16x32_bf16(k1, qf[j][1], a, 0, 0, 0); s[kt] = a; }
                  const int qpos = tq0 + q; float mx = -1e30f;
#pragma unroll
                  for (int kt = 0; kt < 9; ++kt)
#pragma unroll
                      for (int e = 0; e < 4; ++e) { const int kp = tq0 - 128 + 16 * kt + 4 * g + e; const bool ok = (kp >= 0) && (kp <= qpos) && (kp > qpos - 128); const float v = ok ? s[kt][e] * (0.125f * 1.4426950408889634f) : -1e30f; s[kt][e] = v; mx = fmaxf(mx, v); }
                  mx = fmaxf(mx, __shfl_xor(mx, 16)); mx = fmaxf(mx, __shfl_xor(mx, 32)); mx = fmaxf(mx, sink);
                  float l = 0.f;
#pragma unroll
                  for (int kt = 0; kt < 9; ++kt)
#pragma unroll
                      for (int e = 0; e < 4; ++e) { const float p = __builtin_amdgcn_exp2f(s[kt][e] - mx); s[kt][e] = p; l += p; }
                  l += __shfl_xor(l, 16); l += __shfl_xor(l, 32);
                  const float rden = __builtin_amdgcn_rcpf(l + __builtin_amdgcn_exp2f(sink - mx));
                  f32x4 o[4];
#pragma unroll
                  for (int dt = 0; dt < 4; ++dt) o[dt] = (f32x4){0.f, 0.f, 0.f, 0.f};
#pragma unroll
                  for (int s2 = 0; s2 < 5; ++s2) {
                      v4u pw; pw.x = cvt_pk_bf16(s[2 * s2][0], s[2 * s2][1]); pw.y = cvt_pk_bf16(s[2 * s2][2], s[2 * s2][3]);
                      if (s2 < 4) { pw.z = cvt_pk_bf16(s[2 * s2 + 1][0], s[2 * s2 + 1][1]); pw.w = cvt_pk_bf16(s[2 * s2 + 1][2], s[2 * s2 + 1][3]); } else { pw.z = 0u; pw.w = 0u; }
                      const bf16x8 pf = __builtin_bit_cast(bf16x8, pw);
#pragma unroll
                      for (int dt = 0; dt < 4; ++dt) { const LAS unsigned char* vp = vsb + (16 * (j + 2 * s2)) * KPITCH + dt * 32;
                          const s16x4 va = vtr(vp), vb = vtr(vp + ((s2 < 4) ? 16 * KPITCH : 0)); const bf16x8 vf = (bf16x8){va[0], va[1], va[2], va[3], vb[0], vb[1], vb[2], vb[3]};
                          o[dt] = __builtin_amdgcn_mfma_f32_16x16x32_bf16(vf, pf, o[dt], 0, 0, 0); }
                  }
                  bf16* op = MIX + (rb + (tq0 - NMETA) + q) * DM + PW + 64 * h + 4 * g;
#pragma unroll
                  for (int dt = 0; dt < 4; ++dt) { v2u w; w.x = cvt_pk_bf16(o[dt][0] * rden, o[dt][1] * rden); w.y = cvt_pk_bf16(o[dt][2] * rden, o[dt][3] * rden); *(v2u*)(op + 16 * dt) = w; }
              } }
            __syncthreads();
        }
        for (int su = vcu; su < 2 * DB; su += G) {
            const int i = su >> 1, kv = su & 1; const size_t r = (size_t)TAIL0 + NMETA + i;
            f32x4 kr4[4], vr4[4];
#pragma unroll
            for (int it = 0; it < 4; ++it) { int ch = tid + it * NTHR; ch = ch < 2032 ? ch : 2031; const int row = ch >> 4, c = ch & 15; const size_t off = ((size_t)i * 128 + row + 1) * KVW + 64 * kv + 4 * c;
                kr4[it] = *(const f32x4*)(cache_k + off); vr4[it] = *(const f32x4*)(cache_v + off); }
            v4u knew = (v4u){0u, 0u, 0u, 0u}, vnew = (v4u){0u, 0u, 0u, 0u};
            if (tid < 8) { knew = *(const v4u*)(Kb + r * KVW + 64 * kv + 8 * tid); vnew = *(const v4u*)(Vb + r * KVW + 64 * kv + 8 * tid); }
            if (kv == 0) {
                const int c = tid, w = 2 << (c >> 7); const float cur = bf2f(Ub[r * PW + c]); const float* sp = state_pool + (size_t)i * 15 * PW + c; float xs[15];
#pragma unroll
                for (int k = 0; k < 15; ++k) xs[k] = sp[(size_t)k * PW];
                float S = cur;
#pragma unroll
                for (int k = 0; k < 15; ++k) S += (k >= 16 - w) ? xs[k] : 0.f;
                const float d = S / (float)w - cur; MIX[r * DM + c] = (bf16)(cvt_pk_bf16(d, 0.f) & 0xffffu);
            }
#pragma unroll
            for (int it = 0; it < 4; ++it) { const int ch = tid + it * NTHR; if (ch < 2032) { const int row = ch >> 4, c = ch & 15, off = row * KPITCH + c * 8;
                v2u a; a.x = cvt_pk_bf16(kr4[it].x, kr4[it].y); a.y = cvt_pk_bf16(kr4[it].z, kr4[it].w); *(LAS v2u*)(lds + off) = a;
                v2u bq; bq.x = cvt_pk_bf16(vr4[it].x, vr4[it].y); bq.y = cvt_pk_bf16(vr4[it].z, vr4[it].w); *(LAS v2u*)(lds + VS_OFF + off) = bq; } }
            if (tid < 8) { *(LAS v4u*)(lds + 127 * KPITCH + tid * 16) = knew; *(LAS v4u*)(lds + VS_OFF + 127 * KPITCH + tid * 16) = vnew; }
            __syncthreads();
            if (wave == 0) {
                const int q = lane & 15, g = lane >> 4, hq = 4 * kv + (q & 3); const float sink = sinks[hq] * 1.4426950408889634f;
                const bf16* qp = Qb + r * PW + 64 * hq + 8 * g; const bf16x8 qf0 = *(const bf16x8*)(qp), qf1 = *(const bf16x8*)(qp + 32);
                const LAS unsigned char* vsb = lds + VS_OFF + (4 * g + ((lane >> 2) & 3)) * KPITCH + (lane & 3) * 8;
                f32x4 s[8]; float mx = -1e30f;
#pragma unroll
                for (int kt = 0; kt < 8; ++kt) { const LAS unsigned char* kp = lds + (16 * kt + q) * KPITCH + 16 * g;
                    const bf16x8 k0 = *(const LAS bf16x8*)(kp), k1 = *(const LAS bf16x8*)(kp + 64);
                    f32x4 a = (f32x4){0.f, 0.f, 0.f, 0.f}; a = __builtin_amdgcn_mfma_f32_16x16x32_bf16(k0, qf0, a, 0, 0, 0); a = __builtin_amdgcn_mfma_f32_16x16x32_bf16(k1, qf1, a, 0, 0, 0);
                    a = a * (0.125f * 1.4426950408889634f); s[kt] = a; mx = fmaxf(fmaxf(mx, fmaxf(a[0], a[1])), fmaxf(a[2], a[3])); }
                mx = fmaxf(mx, __shfl_xor(mx, 16)); mx = fmaxf(mx, __shfl_xor(mx, 32)); mx = fmaxf(mx, sink);
                float l = 0.f;
#pragma unroll
                for (int kt = 0; kt < 8; ++kt)
#pragma unroll
                    for (int e = 0; e < 4; ++e) { const float p = __builtin_amdgcn_exp2f(s[kt][e] - mx); s[kt][e] = p; l += p; }
                l += __shfl_xor(l, 16); l += __shfl_xor(l, 32);
                const float rden = __builtin_amdgcn_rcpf(l + __builtin_amdgcn_exp2f(sink - mx));
                f32x4 o[4];
#pragma unroll
                for (int dt = 0; dt < 4; ++dt) o[dt] = (f32x4){0.f, 0.f, 0.f, 0.f};
#pragma unroll
                for (int s2 = 0; s2 < 4; ++s2) {
                    v4u pw; pw.x = cvt_pk_bf16(s[2 * s2][0], s[2 * s2][1]); pw.y = cvt_pk_bf16(s[2 * s2][2], s[2 * s2][3]); pw.z = cvt_pk_bf16(s[2 * s2 + 1][0], s[2 * s2 + 1][1]); pw.w = cvt_pk_bf16(s[2 * s2 + 1][2], s[2 * s2 + 1][3]);
                    const bf16x8 pf = __builtin_bit_cast(bf16x8, pw);
#pragma unroll
                    for (int dt = 0; dt < 4; ++dt) { const LAS unsigned char* vp = vsb + (32 * s2) * KPITCH + dt * 32;
                        const s16x4 va = vtr(vp), vb = vtr(vp + 16 * KPITCH); const bf16x8 vf = (bf16x8){va[0], va[1], va[2], va[3], vb[0], vb[1], vb[2], vb[3]};
                        o[dt] = __builtin_amdgcn_mfma_f32_16x16x32_bf16(vf, pf, o[dt], 0, 0, 0); }
                }
                if (q < 4) { bf16* op = MIX + r * DM + PW + 64 * hq + 4 * g;
#pragma unroll
                    for (int dt = 0; dt < 4; ++dt) { v2u w; w.x = cvt_pk_bf16(o[dt][0] * rden, o[dt][1] * rden); w.y = cvt_pk_bf16(o[dt][2] * rden, o[dt][3] * rden); *(v2u*)(op + 16 * dt) = w; } }
            }
            __syncthreads();
        }
        for (int i = vcu * NTHR + tid; i < NMETA * (DM / 8); i += G * NTHR) ((v4u*)(MIX + (size_t)TAIL0 * DM))[i] = (v4u){0u, 0u, 0u, 0u};
    }
    SEAM(4);
    if (IN(5)) { TAIL_RES(1, DM, MIX, WOUT, SST + 2 * NTAIL * 32);
        { pg8::Gemm g{MIX, WOUT, MAIN, DM, DM}; pg8::StaticOrder S; S.init(MAIN, DM, G, bx); EpiRes<1> E{};
        pg8::gemm_phase<EpiRes<1>, pg8::StaticOrder, true, true, DM>(lds, g, S, E); }  }
    SEAM(5);
    if (IN(6)) { TAIL_SWIGLU(W2GU, SST + 2 * NTAIL * 32);
        { pg8::Gemm g{XB, W2GU, MAIN, NGU, DM}; pg8::StaticOrder S; S.init(MAIN, NGU, G, bx); BUILD_RST(S); EpiSwiGLU E{RST};
        pg8::gemm_phase<EpiSwiGLU, pg8::StaticOrder, true, true, DM>(lds, g, S, E); }  }
    SEAM(6);
    if (IN(7)) { TAIL_RES(2, DFF, ACT, W2D, SST);
        { pg8::Gemm g{ACT, W2D, MAIN, DM, DFF}; pg8::StaticOrder S; S.init(MAIN, DM, G, bx); EpiRes<2> E{};
        pg8::gemm_phase<EpiRes<2>, pg8::StaticOrder, true, true, DFF, true>(lds, g, S, E); }  }
#undef IN
#undef SEAM
}

extern "C" void kernel_launch(void* const* d_in, const int* in_sizes, int n_in, void* d_out, int out_size, void* d_ws, size_t ws_size, hipStream_t stream) {
    static int grid = 0;
    if (grid == 0) {
        if (n_in != 22 || (size_t)out_size != O_END || ws_size < WS_END) { fprintf(stderr, "kernel_launch: unexpected shapes: n_in %d out %d ws %zu (need %zu)\n", n_in, out_size, ws_size, (size_t)WS_END); grid = -1; return; }
        int dev = 0, cus = 0, per_cu = 0;
        if (hipGetDevice(&dev) != hipSuccess || hipDeviceGetAttribute(&cus, hipDeviceAttributeMultiprocessorCount, dev) != hipSuccess) { grid = -1; return; }
        if (hipFuncSetAttribute((const void*)hymba_fwd, hipFuncAttributeMaxDynamicSharedMemorySize, LDS_BYTES) != hipSuccess) { fprintf(stderr, "kernel_launch: hipFuncSetAttribute failed\n"); grid = -1; return; }
        if (hipOccupancyMaxActiveBlocksPerMultiprocessor(&per_cu, (const void*)hymba_fwd, NTHR, LDS_BYTES) != hipSuccess || per_cu < 1) { fprintf(stderr, "kernel_launch: occupancy query says %d\n", per_cu); per_cu = 1; }
        (void)hipGetLastError();
        grid = cus * 1;
    }
    if (grid < 0) return;
    if (hipMemsetAsync((char*)d_ws + WS_CTL, 0, 65536, stream) != hipSuccess) { fprintf(stderr, "kernel_launch: memset failed\n"); return; }
    Args a{};
    for (int i = 0; i < 22; ++i) a.in[i] = (const float*)d_in[i];
    a.out = (float*)d_out; a.ws = (unsigned char*)d_ws;
    for (int i = 0; i < 8; ++i) { const float e = (float)(-13.122363377404328) * (float)i * 0.125f; a.invf[i] = (float)std::exp((double)e); }
#if MK_N_LAUNCHES == 1
    a.ph_lo = 0; a.ph_hi = 8;
    void* kargs[] = {&a};
    const hipError_t e = hipLaunchCooperativeKernel((const void*)hymba_fwd, dim3(grid), dim3(NTHR), kargs, LDS_BYTES, stream);
    if (e != hipSuccess) fprintf(stderr, "kernel_launch: cooperative launch failed: %s (grid %d)\n", hipGetErrorString(e), grid);
#ifdef PROBE_PHASE
    a.ph_lo = PROBE_PHASE; a.ph_hi = PROBE_PHASE + 1; hipLaunchKernelGGL(hymba_fwd, dim3(grid), dim3(NTHR), LDS_BYTES, stream, a);
#endif
#else
    for (int p = 0; p < 8; ++p) { a.ph_lo = p; a.ph_hi = p + 1; hipLaunchKernelGGL(hymba_fwd, dim3(grid), dim3(NTHR), LDS_BYTES, stream, a); }
#endif
}
```

```cpp
#include <hip/hip_runtime.h>
#include <hip/hip_cooperative_groups.h>
#include <cstdio>
#include <cstdint>
#include <cmath>
namespace cg = cooperative_groups;
namespace pg8 {
#define PG8_LAS __attribute__((address_space(3)))
typedef unsigned short bf16_t;
typedef short bf16x8 __attribute__((ext_vector_type(8)));
typedef float f32x4 __attribute__((ext_vector_type(4)));
typedef unsigned u32x4 __attribute__((ext_vector_type(4)));
constexpr int BM = 256, BK = 64, HALF = 128, HTB = HALF * BK * 2  , STAGE_BYTES = 8 * HTB, NXCD = 8, WGM = 4;

__host__ __device__ __forceinline__ int lds_byte(int r, int c) { const int st = (r >> 4) * 2 + (c >> 5), rr = r & 15, cc = c & 31, ob = rr * 64 + cc * 2; return st * 1024 + (ob ^ (((ob >> 9) & 1) << 5)); }
__host__ __device__ __forceinline__ void stage_rc(int b, int& R, int& C) { const int st = b / 1024, sb = b % 1024, swz = sb ^ (((sb >> 9) & 1) << 5); R = (st >> 1) * 16 + swz / 64; C = (st & 1) * 32 + (swz % 64) / 2; }
__host__ __device__ __forceinline__ int perm32(int rho) { const int n = rho >> 4, i = rho & 15; return 8 * (i >> 2) + 4 * n + (i & 3); }

struct Unit { int pm, pn, ui; };
struct Gemm { const bf16_t* A; const bf16_t* Bt; int M, N, K; };

struct StaticOrder {
    int nM, nN, nwg, G, c;
    __host__ __device__ void init(int M, int N, int G_, int c_) { nM = M / BM; nN = N / BM; nwg = nM * nN; G = G_; c = c_; }
    __host__ __device__ bool next(int i, Unit& u) const {
        const long L = (long)i * G + c; if (L >= nwg) return false;
        int wgid = (int)L; { const int q = nwg / NXCD, r = nwg % NXCD, xcd = wgid % NXCD, off = wgid / NXCD; wgid = (xcd < r ? xcd * (q + 1) : r * (q + 1) + (xcd - r) * q) + off; }
        const int nig = WGM * nN, gid = wgid / nig, fm = gid * WGM, gsz = (nM - fm) < WGM ? (nM - fm) : WGM;
        u.pm = fm + ((wgid % nig) % gsz); u.pn = (wgid % nig) / gsz; u.ui = i; return true;
    }
    __device__ __forceinline__ void a_ready(const Unit&) const {}
    __device__ __forceinline__ void done(const Unit&) const {}
};

__device__ __forceinline__ unsigned cvt_pk_bf16(float lo, float hi) { unsigned r; asm volatile("v_cvt_pk_bf16_f32 %0, %1, %2" : "=v"(r) : "v"(lo), "v"(hi)); return r; }
typedef float f32x2 __attribute__((ext_vector_type(2)));
template <class Epi, class Sched, bool ALIGN_EPI, bool SP2, int KC, bool ATILED = false>
__device__ __forceinline__ void gemm_phase(PG8_LAS unsigned char* lds, const Gemm g, const Sched& S, const Epi& E) {
    const int tid = threadIdx.x, wid = __builtin_amdgcn_readfirstlane(tid >> 6), lane = tid & 63, wr = wid >> 2, wc = wid & 3, fr = lane & 15, fq = lane >> 4;
    constexpr int K = KC, nt = K / BK;
    unsigned voffA[2], voffB[2];
#pragma unroll
    for (int i = 0; i < 2; ++i) { int R, C; stage_rc(tid * 16 + i * 8192, R, C); const int Rb = Epi::PERM ? ((R & ~31) + perm32(R & 31)) : R;
        voffA[i] = (unsigned)(R * (ATILED ? BK : K) + C) * 2u; voffB[i] = (unsigned)(Rb * K + C) * 2u; }
    const size_t kstep = (size_t)(BK * 2);
    const size_t kstepA = ATILED ? (size_t)(BM * BK * 2) : kstep, hstepA = ATILED ? (size_t)(HALF * BK * 2) : (size_t)HALF * K * 2;
    const size_t hstep = (size_t)HALF * K * 2;
    const size_t tstep = 2 * hstep;
    const unsigned ldsw = (unsigned)wid * 1024u;
    const int aoff = lds_byte(wr * 64 + fr, fq * 8), boff = lds_byte(wc * 32 + fr, fq * 8);
#define PG8_SA(b, h) (((b) * 2 + (h)) * HTB)
#define PG8_SB(b, h) ((4 + (b) * 2 + (h)) * HTB)
#define PG8_STAGE(bufoff, gbase, voff) do { _Pragma("unroll") for (int _i = 0; _i < 2; ++_i) \
        __builtin_amdgcn_global_load_lds((const unsigned*)((const char*)(gbase) + (voff)[_i]), (PG8_LAS unsigned*)(lds + (bufoff) + ldsw + _i * 8192), 16, 0, 0); } while (0)
#define PG8_LDA(dst, b, h) do { _Pragma("unroll") for (int m = 0; m < 4; ++m) _Pragma("unroll") for (int k = 0; k < 2; ++k) dst[m][k] = *(const PG8_LAS bf16x8*)(lds + PG8_SA(b, h) + aoff + m * 2048 + k * 1024); } while (0)
#define PG8_LDB(dst, b, h) do { _Pragma("unroll") for (int n = 0; n < 2; ++n) _Pragma("unroll") for (int k = 0; k < 2; ++k) dst[n][k] = *(const PG8_LAS bf16x8*)(lds + PG8_SB(b, h) + boff + n * 2048 + k * 1024); } while (0)
#define PG8_MMA(ai, bj, At, Bt) do { __builtin_amdgcn_s_setprio(1); _Pragma("unroll") for (int m = 0; m < 4; ++m) _Pragma("unroll") for (int n = 0; n < 2; ++n) _Pragma("unroll") for (int k = 0; k < 2; ++k) \
        acc[ai][bj][m][n] = __builtin_amdgcn_mfma_f32_16x16x32_bf16(Bt[n][k], At[m][k], acc[ai][bj][m][n], 0, 0, 0); __builtin_amdgcn_s_setprio(0); } while (0)
#define PG8_WAIT_V(n) asm volatile("s_waitcnt vmcnt(" #n ")" ::: "memory")
#define PG8_WAIT_L(n) asm volatile("s_waitcnt lgkmcnt(" #n ")" ::: "memory")
#define PG8_BAR __builtin_amdgcn_s_barrier()
#define PG8_SCHED __builtin_amdgcn_sched_barrier(0)
    Unit cur, nxt; int ui = 0;
    if (!S.next(0, cur)) return;
    f32x4 acc[2][2][4][2];
#pragma unroll
    for (int a = 0; a < 2; ++a)
#pragma unroll
        for (int b = 0; b < 2; ++b)
#pragma unroll
            for (int m = 0; m < 4; ++m)
#pragma unroll
                for (int n = 0; n < 2; ++n) acc[a][b][m][n] = (f32x4){0.f, 0.f, 0.f, 0.f};
    bf16x8 At[4][2], B0[2][2], B1[2][2];
    const char* cA = (const char*)g.A + (size_t)cur.pm * tstep; const char* cB = (const char*)g.Bt + (size_t)cur.pn * tstep;
    S.a_ready(cur);
    if constexpr (SP2) {
        PG8_STAGE(PG8_SB(0, 0), cB, voffB); PG8_STAGE(PG8_SB(0, 1), cB + hstep, voffB); PG8_STAGE(PG8_SA(0, 0), cA, voffA); PG8_STAGE(PG8_SA(0, 1), cA + hstepA, voffA);
        if (wr == 1) PG8_BAR;
        PG8_WAIT_V(2); PG8_BAR;
        PG8_STAGE(PG8_SB(1, 0), cB + kstep, voffB); PG8_STAGE(PG8_SA(1, 0), cA + kstepA, voffA); PG8_STAGE(PG8_SB(1, 1), cB + hstep + kstep, voffB);
        PG8_WAIT_V(6); PG8_BAR;
    } else {
        PG8_STAGE(PG8_SB(0, 0), cB, voffB); PG8_STAGE(PG8_SA(0, 0), cA, voffA); PG8_STAGE(PG8_SB(0, 1), cB + hstep, voffB); PG8_STAGE(PG8_SA(0, 1), cA + hstepA, voffA);
        if (wr == 1) PG8_BAR;
        PG8_WAIT_V(4); PG8_BAR;
        PG8_STAGE(PG8_SB(1, 0), cB + kstep, voffB); PG8_STAGE(PG8_SA(1, 0), cA + kstepA, voffA); PG8_STAGE(PG8_SB(1, 1), cB + hstep + kstep, voffB);
        PG8_WAIT_V(6); PG8_BAR;
    }
    for (;;) {
        const bool has_next = S.next(ui + 1, nxt);
        const char* nA = has_next ? (const char*)g.A + (size_t)nxt.pm * tstep : cA; const char* nB = has_next ? (const char*)g.Bt + (size_t)nxt.pn * tstep : cB;
        for (int t = 0; t < nt; t += 2) {
            const bool last = (t == nt - 2);
            const char* a1 = cA + (size_t)(t + 1) * kstepA;
            const char* a2 = last ? nA : cA + (size_t)(t + 2) * kstepA; const char* b2 = last ? nB : cB + (size_t)(t + 2) * kstep;
            const char* a3 = a2 + kstepA; const char* b3 = b2 + kstep;
            if (last && has_next) S.a_ready(nxt);
            if constexpr (SP2) {
            PG8_LDB(B0, 0, 0); PG8_LDB(B1, 0, 1); PG8_SCHED; PG8_LDA(At, 0, 0); PG8_STAGE(PG8_SA(1, 1), a1 + hstepA, voffA);
            PG8_WAIT_V(8); PG8_WAIT_L(0); PG8_BAR; PG8_MMA(0, 0, At, B0); PG8_MMA(0, 1, At, B1); PG8_BAR; PG8_SCHED;
            PG8_LDA(At, 0, 1); PG8_STAGE(PG8_SB(0, 0), b2, voffB); PG8_STAGE(PG8_SB(0, 1), b2 + hstep, voffB); PG8_STAGE(PG8_SA(0, 0), a2, voffA);
            PG8_WAIT_V(8); PG8_WAIT_L(0); PG8_BAR; PG8_MMA(1, 0, At, B0); PG8_MMA(1, 1, At, B1); PG8_BAR; PG8_SCHED;
            PG8_LDB(B0, 1, 0); PG8_LDB(B1, 1, 1); PG8_SCHED; PG8_LDA(At, 1, 0); PG8_STAGE(PG8_SA(0, 1), a2 + hstepA, voffA);
            PG8_WAIT_V(8); PG8_WAIT_L(0); PG8_BAR; PG8_MMA(0, 0, At, B0); PG8_MMA(0, 1, At, B1); PG8_BAR; PG8_SCHED;
            PG8_LDA(At, 1, 1); PG8_STAGE(PG8_SB(1, 0), b3, voffB); PG8_STAGE(PG8_SB(1, 1), b3 + hstep, voffB); PG8_STAGE(PG8_SA(1, 0), a3, voffA);
            PG8_WAIT_V(8); PG8_WAIT_L(0); PG8_BAR; PG8_MMA(1, 0, At, B0); PG8_MMA(1, 1, At, B1); PG8_BAR; PG8_SCHED;
            } else {
            PG8_LDB(B0, 0, 0); PG8_SCHED; PG8_LDA(At, 0, 0); PG8_STAGE(PG8_SA(1, 1), a1 + hstepA, voffA);
            PG8_WAIT_L(8); PG8_BAR; PG8_WAIT_L(0); PG8_MMA(0, 0, At, B0); PG8_BAR; PG8_SCHED;
            PG8_LDB(B1, 0, 1); PG8_STAGE(PG8_SB(0, 0), b2, voffB);
            PG8_BAR; PG8_WAIT_L(0); PG8_MMA(0, 1, At, B1); PG8_BAR;
            PG8_LDA(At, 0, 1); PG8_STAGE(PG8_SA(0, 0), a2, voffA);
            PG8_BAR; PG8_WAIT_L(0); PG8_MMA(1, 0, At, B0); PG8_BAR; PG8_SCHED;
            PG8_STAGE(PG8_SB(0, 1), b2 + hstep, voffB);
            PG8_WAIT_V(6); PG8_BAR; PG8_MMA(1, 1, At, B1); PG8_BAR;
            PG8_LDB(B0, 1, 0); PG8_SCHED; PG8_LDA(At, 1, 0); PG8_STAGE(PG8_SA(0, 1), a2 + hstepA, voffA);
            PG8_WAIT_L(8); PG8_BAR; PG8_WAIT_L(0); PG8_MMA(0, 0, At, B0); PG8_BAR; PG8_SCHED;
            PG8_LDB(B1, 1, 1); PG8_STAGE(PG8_SB(1, 0), b3, voffB);
            PG8_BAR; PG8_WAIT_L(0); PG8_MMA(0, 1, At, B1); PG8_BAR;
            PG8_LDA(At, 1, 1); PG8_STAGE(PG8_SA(1, 0), a3, voffA);
            PG8_BAR; PG8_WAIT_L(0); PG8_MMA(1, 0, At, B0); PG8_BAR; PG8_SCHED;
            PG8_STAGE(PG8_SB(1, 1), b3 + hstep, voffB);
            PG8_WAIT_V(6); PG8_BAR; PG8_MMA(1, 1, At, B1); PG8_BAR;
            }
        }
        if constexpr (ALIGN_EPI) { if (wr == 0) PG8_BAR; }
        if constexpr (!Epi::AFTER_DRAIN) { E(acc, cur, wr, wc, fr, fq); S.done(cur); }
        if (!has_next) break;
#pragma unroll
        for (int a = 0; a < 2; ++a)
#pragma unroll
            for (int b = 0; b < 2; ++b)
#pragma unroll
                for (int m = 0; m < 4; ++m)
#pragma unroll
                    for (int n = 0; n < 2; ++n) acc[a][b][m][n] = (f32x4){0.f, 0.f, 0.f, 0.f};
        cur = nxt; cA = nA; cB = nB; ++ui;
        if constexpr (ALIGN_EPI) { if (wr == 1) PG8_BAR; }
    }
    PG8_WAIT_V(0);
    if constexpr (!ALIGN_EPI) { if (wr == 0) PG8_BAR; }
    PG8_BAR;
    if constexpr (Epi::AFTER_DRAIN) { E.fused(acc, cur, wr, wc, fr, fq, lds, wid, lane); S.done(cur); }
#undef PG8_SA
#undef PG8_SB
#undef PG8_STAGE
#undef PG8_LDA
#undef PG8_LDB
#undef PG8_MMA
#undef PG8_WAIT_V
#undef PG8_WAIT_L
#undef PG8_BAR
#undef PG8_SCHED
}
}

#ifndef MK_N_LAUNCHES
#define MK_N_LAUNCHES 1
#endif
constexpr int NWAVES = 8, NTHR = 512;
constexpr int DM = 1024, NB = 16, SEQ = 2048, NMETA = 16, TT = SEQ + NMETA, DB = 128;
constexpr int MAIN = NB * SEQ;
constexpr int TAIL0 = MAIN, NTAIL = 144;
constexpr int MPAD = 33024;
constexpr int DFF = 2816, NGU = 2 * DFF, NIN = 1280, PW = 512, NH = 8, HD = 64, KVW = 128;
constexpr int PASTLEN = 16384, NPOS = TT + 1;
constexpr float EPS = 1e-6f;
constexpr size_t O_Y = 0, O_YS = 33554432, O_PP = 33685504, O_KP = 33808384, O_VP = 34070528, O_PS = 34332672, O_KS = 35315712, O_VS = 37412864, O_END = 39510016;
constexpr size_t MiB = 1u << 20;
constexpr size_t WS_CTL = 0, WS_ROPE = 1 * MiB, WS_SS = 2 * MiB, WS_SST = 4 * MiB + 65536, WS_W1GU = 5 * MiB, WS_W1D = 16 * MiB, WS_WIN = 22 * MiB, WS_WOUT = 25 * MiB, WS_W2GU = 27 * MiB, WS_W2D = 38 * MiB,
                 WS_XB = 44 * MiB, WS_X = 109 * MiB, WS_ACT = 239 * MiB, WS_U = 239 * MiB, WS_Q = 272 * MiB, WS_K = 305 * MiB, WS_V = 314 * MiB, WS_MIX = 323 * MiB, WS_END = 418 * MiB;
static_assert(WS_SS + (size_t)MAIN * 16 * 4 <= WS_SST && WS_SST + 3 * NTAIL * 32 * 4 <= WS_W1GU && WS_XB + (size_t)MPAD * DM * 2 <= WS_X && WS_X + (size_t)MPAD * DM * 4 <= WS_ACT && WS_ACT + (size_t)MPAD * DFF * 2 <= WS_END, "ws map");
static_assert(WS_U + (size_t)MPAD * PW * 2 <= WS_Q && WS_Q + (size_t)MPAD * PW * 2 <= WS_K && WS_K + (size_t)MPAD * KVW * 2 <= WS_V && WS_V + (size_t)MPAD * KVW * 2 <= WS_MIX && WS_MIX + (size_t)MPAD * DM * 2 <= WS_END, "ws overlay");
constexpr int RING_BYTES = 131072, LDS_BYTES = 147456;

#define LAS __attribute__((address_space(3)))
typedef unsigned short bf16;
typedef unsigned v4u __attribute__((ext_vector_type(4)));
typedef unsigned v2u __attribute__((ext_vector_type(2)));
typedef float f32x4 __attribute__((ext_vector_type(4)));
typedef short bf16x8 __attribute__((ext_vector_type(8)));
typedef short s16x4 __attribute__((ext_vector_type(4)));
#define LDS_WAIT() asm volatile("s_waitcnt lgkmcnt(0)" ::: "memory")
#define RLX_AGENT __ATOMIC_RELAXED, __HIP_MEMORY_SCOPE_AGENT
#define XB_TMO      128
#define XB_XCNT(j)  (256  + 64 * (j))
#define XB_XSUB(j)  (1280 + 64 * (j))
#define XB_XGEN(j)  (2304 + 64 * (j))
#define XB_TOP      3328
#define XB_TOPGEN   3392
#define XCD_BAR_WORDS 3456
#define XB_SPIN_CAP (1u << 18)

__device__ __forceinline__ unsigned xb_ld(unsigned* p)              { return __hip_atomic_load(p, __ATOMIC_RELAXED, __HIP_MEMORY_SCOPE_AGENT); }
__device__ __forceinline__ unsigned xb_add(unsigned* p, unsigned v) { return __hip_atomic_fetch_add(p, v, __ATOMIC_RELAXED, __HIP_MEMORY_SCOPE_AGENT); }
__device__ __forceinline__ unsigned xb_xcc_id() { return (unsigned)__builtin_amdgcn_s_getreg((3 << 11) | 20) & 0xFu; }
#define XB_SPIN(cond, bar) do { unsigned _sp = 0; while (cond) { __builtin_amdgcn_s_sleep(1); \
    if ((++_sp & 255u) == 0u) { if (xb_ld(&(bar)[XB_TMO])) break; if (_sp > XB_SPIN_CAP) { atomicAdd(&(bar)[XB_TMO], 1u); break; } } } } while (0)

struct XcdBarrier {
    unsigned* bar; unsigned x;
    volatile LAS unsigned* st;
};

__device__ __forceinline__ XcdBarrier xcd_barrier_post(unsigned* bar, volatile LAS unsigned* st) {
    XcdBarrier b; b.bar = bar; b.x = xb_xcc_id(); b.st = st;
    if (threadIdx.x == 0) (void)xb_add(&bar[XB_XCNT(b.x)], 1u);
    return b;
}
__device__ __forceinline__ void xcd_barrier_complete(unsigned* bar, unsigned x, unsigned& nloc, unsigned& nx) {
    const unsigned G = gridDim.x * gridDim.y * gridDim.z;
    unsigned sum, cnt, mine, sp = 0u;
    for (;;) {
        sum = 0u; cnt = 0u; mine = 0u;
#pragma unroll
        for (unsigned j = 0; j < 16; ++j) { const unsigned c = xb_ld(&bar[XB_XCNT(j)]); sum += c; cnt += (c > 0u) ? 1u : 0u; mine = (j == x) ? c : mine; }
        if (sum == G) break;
        __builtin_amdgcn_s_sleep(1);
        if ((++sp & 255u) == 0u) { if (xb_ld(&bar[XB_TMO])) break; if (sp > XB_SPIN_CAP) { atomicAdd(&bar[XB_TMO], 1u); break; } }
    }
    nloc = mine > 0u ? mine : 1u; nx = cnt > 0u ? cnt : 1u;
}

__device__ __forceinline__ void xcd_barrier(const XcdBarrier& b) {
    asm volatile("s_waitcnt vmcnt(0)" ::: "memory");
    __syncthreads();
    if (threadIdx.x == 0) {
        unsigned* bar = b.bar;
        __builtin_amdgcn_s_waitcnt(0);
        unsigned nloc = b.st[0], nx = b.st[1];
        if (nloc == 0u) { xcd_barrier_complete(bar, b.x, nloc, nx); b.st[0] = nloc; b.st[1] = nx; }
        const unsigned old = xb_add(&bar[XB_XSUB(b.x)], 1u);
        const unsigned gen = old / nloc;
        if (old + 1u == (gen + 1u) * nloc) {
            __builtin_amdgcn_fence(__ATOMIC_RELEASE, "agent");
            asm volatile("s_waitcnt vmcnt(0)" ::: "memory");
            const unsigned og = xb_add(&bar[XB_TOP], 1u);
            const unsigned tg = og / nx;
            if (og + 1u == (tg + 1u) * nx) xb_add(&bar[XB_TOPGEN], 1u);
            else XB_SPIN(xb_ld(&bar[XB_TOPGEN]) == tg, bar);
            __builtin_amdgcn_fence(__ATOMIC_ACQUIRE, "agent");
            xb_add(&bar[XB_XGEN(b.x)], 1u);
            asm volatile("s_waitcnt vmcnt(0)" ::: "memory");
        } else {
            XB_SPIN(xb_ld(&bar[XB_XGEN(b.x)]) == gen, bar);
            __builtin_amdgcn_fence(__ATOMIC_ACQUIRE, "agent");
            asm volatile("s_waitcnt vmcnt(0)" ::: "memory");
        }
    }
    __syncthreads();
}


using pg8::cvt_pk_bf16;
typedef short v4i16_t __attribute__((ext_vector_type(4)));
__device__ __forceinline__ s16x4 vtr(const LAS unsigned char* p) { return __builtin_bit_cast(s16x4, __builtin_amdgcn_ds_read_tr16_b64_v4i16((LAS v4i16_t*)p)); }
__device__ __forceinline__ float bf2f(unsigned short h) { return __uint_as_float((unsigned)h << 16); }
__device__ __forceinline__ float row_rstd(const float* SS, int r) {
    const f32x4* p = (const f32x4*)(SS + (size_t)r * 16);
    const f32x4 a = p[0], b = p[1], c = p[2], d = p[3]; const f32x4 s = (a + b) + (c + d);
    return __builtin_amdgcn_rsqf(((s.x + s.y) + (s.z + s.w)) * (1.0f / DM) + EPS);
}
__device__ __forceinline__ float silu_mul(float g, float u) { return g * __builtin_amdgcn_rcpf(1.0f + __builtin_amdgcn_exp2f(-1.4426950408889634f * g)) * u; }

struct Args {
    const float* in[22]; float* out; unsigned char* ws; float invf[8]; int ph_lo, ph_hi;
};
typedef const __attribute__((address_space(4))) Args* KArgs;
__device__ __forceinline__ KArgs kargs_now() { KArgs ka = (KArgs)__builtin_amdgcn_kernarg_segment_ptr(); asm volatile("" : "+s"(ka)); return ka; }
struct EpiSwiGLU {
    static constexpr bool PERM = true, AFTER_DRAIN = false;
    const LAS float* rst;
    __device__ __forceinline__ void operator()(const f32x4 (&acc)[2][2][4][2], const pg8::Unit& u, int wr, int wc, int fr, int fq) const {
        const KArgs ka = kargs_now(); unsigned char* ws = ka->ws; bf16* O = (bf16*)(ws + WS_ACT); const LAS float* rt = rst + u.ui * 256 + wr * 64 + fr;
        const int row0 = u.pm * 256 + wr * 64 + fr, col0 = u.pn * 128 + wc * 32 + 8 * fq;
#pragma unroll
        for (int ai = 0; ai < 2; ++ai)
#pragma unroll
            for (int m = 0; m < 4; ++m) {
                const int r = row0 + ai * 128 + m * 16; const float rs = rt[ai * 128 + m * 16];
                const f32x4 g0 = acc[ai][0][m][0] * rs, g1 = acc[ai][0][m][1] * rs, u0 = acc[ai][1][m][0] * rs, u1 = acc[ai][1][m][1] * rs;
                v4u w; w.x = cvt_pk_bf16(silu_mul(g0[0], u0[0]), silu_mul(g0[1], u0[1])); w.y = cvt_pk_bf16(silu_mul(g0[2], u0[2]), silu_mul(g0[3], u0[3]));
                w.z = cvt_pk_bf16(silu_mul(g1[0], u1[0]), silu_mul(g1[1], u1[1])); w.w = cvt_pk_bf16(silu_mul(g1[2], u1[2]), silu_mul(g1[3], u1[3]));
                __builtin_nontemporal_store(w, (v4u*)(O + (size_t)(r >> 8) * (256 * DFF) + (size_t)(col0 >> 6) * (256 * 64) + (r & 255) * 64 + (col0 & 63)));
            }
    }
};
template <int MODE> struct EpiRes {
    static constexpr bool PERM = true, AFTER_DRAIN = false;
    __device__ __forceinline__ void operator()(const f32x4 (&acc)[2][2][4][2], const pg8::Unit& u, int wr, int wc, int fr, int fq) const {
        const KArgs ka = kargs_now(); unsigned char* ws = ka->ws; bf16* XB = (bf16*)(ws + WS_XB); float* SS = (float*)(ws + WS_SS); float* out = ka->out;
        constexpr float alpha = (MODE == 1) ? 1.0f : 0.5f;
        const int col0 = u.pn * 256 + wc * 32 + 8 * fq;
        v4u xin[2][4][2];
#pragma unroll
        for (int ai = 0; ai < 2; ++ai)
#pragma unroll
            for (int m = 0; m < 4; ++m) { const bf16* xrow = XB + (size_t)(u.pm * 256 + ai * 128 + wr * 64 + m * 16 + fr) * DM + col0;
#pragma unroll
                for (int bj = 0; bj < 2; ++bj) xin[ai][m][bj] = *(const v4u*)(xrow + bj * 128); }
#pragma unroll
        for (int ai = 0; ai < 2; ++ai)
#pragma unroll
            for (int m = 0; m < 4; ++m) {
                const int r = u.pm * 256 + ai * 128 + wr * 64 + m * 16 + fr;
                bf16* xrow = XB + (size_t)r * DM + col0; float* dst = out + O_Y + (size_t)r * DM + col0;
                float ss = 0.f;
#pragma unroll
                for (int bj = 0; bj < 2; ++bj) {
                    const v4u xi = xin[ai][m][bj]; f32x4 v0 = acc[ai][bj][m][0] * alpha, v1 = acc[ai][bj][m][1] * alpha;
                    v0[0] += __uint_as_float(xi.x << 16); v0[1] += __uint_as_float(xi.x & 0xffff0000u); v0[2] += __uint_as_float(xi.y << 16); v0[3] += __uint_as_float(xi.y & 0xffff0000u);
                    v1[0] += __uint_as_float(xi.z << 16); v1[1] += __uint_as_float(xi.z & 0xffff0000u); v1[2] += __uint_as_float(xi.w << 16); v1[3] += __uint_as_float(xi.w & 0xffff0000u);
                    if (MODE < 2) { v4u w; w.x = cvt_pk_bf16(v0[0], v0[1]); w.y = cvt_pk_bf16(v0[2], v0[3]); w.z = cvt_pk_bf16(v1[0], v1[1]); w.w = cvt_pk_bf16(v1[2], v1[3]); *(v4u*)(xrow + bj * 128) = w;
                        ss += ((v0[0] * v0[0] + v0[1] * v0[1]) + (v0[2] * v0[2] + v0[3] * v0[3])) + ((v1[0] * v1[0] + v1[1] * v1[1]) + (v1[2] * v1[2] + v1[3] * v1[3])); }
                    else { __builtin_nontemporal_store(v0, (f32x4*)(dst + bj * 128)); __builtin_nontemporal_store(v1, (f32x4*)(dst + bj * 128 + 4)); }
                }
                if (MODE < 2) { ss += __shfl_xor(ss, 16); ss += __shfl_xor(ss, 32); if (fq == 0) SS[(size_t)r * 16 + u.pn * 4 + wc] = ss; }
            }
    }
};
struct EpiIn {
    static constexpr bool PERM = true, AFTER_DRAIN = false;
    const LAS float* rst;
    __device__ __forceinline__ void operator()(const f32x4 (&acc)[2][2][4][2], const pg8::Unit& u, int wr, int wc, int fr, int fq) const {
        const KArgs ka = kargs_now(); unsigned char* ws = ka->ws; const LAS float* rt = rst + u.ui * 256 + wr * 64 + fr; bf16 *U = (bf16*)(ws + WS_U), *Q = (bf16*)(ws + WS_Q), *Kb = (bf16*)(ws + WS_K), *Vb = (bf16*)(ws + WS_V);
        const float* rope = (const float*)(ws + WS_ROPE); const float* qn = ka->in[12]; const float* kn = ka->in[13]; float* out = ka->out;
        const int row0 = u.pm * 256 + wr * 64 + fr;
        if (u.pn < 2) {
            const int col0 = u.pn * 256 + wc * 32 + 8 * fq;
#pragma unroll
            for (int ai = 0; ai < 2; ++ai)
#pragma unroll
                for (int m = 0; m < 4; ++m) {
                    const int r = row0 + ai * 128 + m * 16; const float rs = rt[ai * 128 + m * 16];
                    float* po = nullptr;
                    { const int b = r >> 11, t = (r & (SEQ - 1)) + NMETA; if (t >= TT - 15) po = out + O_PP + ((size_t)b * 15 + (t - (TT - 15))) * PW; }
#pragma unroll
                    for (int bj = 0; bj < 2; ++bj) {
                        const int c = col0 + bj * 128; const f32x4 v0 = acc[ai][bj][m][0] * rs, v1 = acc[ai][bj][m][1] * rs;
                        v4u w; w.x = cvt_pk_bf16(v0[0], v0[1]); w.y = cvt_pk_bf16(v0[2], v0[3]); w.z = cvt_pk_bf16(v1[0], v1[1]); w.w = cvt_pk_bf16(v1[2], v1[3]);
                        *(v4u*)(U + (size_t)r * PW + c) = w;
                        if (po) { *(f32x4*)(po + c) = v0; *(f32x4*)(po + c + 4) = v1; }
                    }
                }
        } else {
            int kind, hcol, ld; bf16* dst; const float* gain; size_t oprompt;
            if (u.pn < 4) { kind = 0; hcol = 64 * (4 * (u.pn - 2) + wc); ld = PW; dst = Q; gain = qn; oprompt = 0; }
            else if (wc < 2) { kind = 1; hcol = 64 * wc; ld = KVW; dst = Kb; gain = kn; oprompt = O_KP; }
            else { kind = 2; hcol = 64 * (wc - 2); ld = KVW; dst = Vb; gain = kn; oprompt = O_VP; }
            const int d0[2] = {fq == 0 ? 0 : 16 + 8 * (fq - 1), fq == 0 ? 8 : 40 + 8 * (fq - 1)};
            f32x4 gv[2][2];
#pragma unroll
            for (int bj = 0; bj < 2; ++bj)
#pragma unroll
                for (int n = 0; n < 2; ++n) gv[bj][n] = *(const f32x4*)(gain + d0[bj] + 4 * n);
            const bool rot = (kind < 2) && (fq == 0);
            f32x4 rcs[8][2], rsn[8][2];
            if (rot) { const float* rp = rope + (size_t)((row0 & (SEQ - 1)) + NMETA) * 16;
#pragma unroll
                for (int n = 0; n < 2; ++n) { rcs[0][n] = *(const f32x4*)(rp + 4 * n); rsn[0][n] = *(const f32x4*)(rp + 8 + 4 * n); } }
#pragma unroll
            for (int ai = 0; ai < 2; ++ai) {
#pragma unroll
                for (int m = 0; m < 4; ++m) {
                    if (rot && (ai * 4 + m) < 7) { const int r1 = row0 + ((ai * 4 + m + 1) >> 2) * 128 + ((ai * 4 + m + 1) & 3) * 16; const float* rp = rope + (size_t)((r1 & (SEQ - 1)) + NMETA) * 16;
#pragma unroll
                        for (int n = 0; n < 2; ++n) { rcs[ai * 4 + m + 1][n] = *(const f32x4*)(rp + 4 * n); rsn[ai * 4 + m + 1][n] = *(const f32x4*)(rp + 8 + 4 * n); } }
                    const int r = row0 + ai * 128 + m * 16; const float rs = rt[ai * 128 + m * 16];
                    f32x4 z[2][2];
#pragma unroll
                    for (int bj = 0; bj < 2; ++bj)
#pragma unroll
                        for (int n = 0; n < 2; ++n) z[bj][n] = acc[ai][bj][m][n] * rs;
                    const int b = r >> 11, t = (r & (SEQ - 1)) + NMETA;
                    if (kind < 2) {
                        float ss = 0.f;
#pragma unroll
                        for (int bj = 0; bj < 2; ++bj)
#pragma unroll
                            for (int n = 0; n < 2; ++n) ss += (z[bj][n][0] * z[bj][n][0] + z[bj][n][1] * z[bj][n][1]) + (z[bj][n][2] * z[bj][n][2] + z[bj][n][3] * z[bj][n][3]);
                        ss += __shfl_xor(ss, 16); ss += __shfl_xor(ss, 32);
                        const float inv = __builtin_amdgcn_rsqf(ss * (1.0f / HD) + EPS);
#pragma unroll
                        for (int bj = 0; bj < 2; ++bj)
#pragma unroll
                            for (int n = 0; n < 2; ++n) z[bj][n] = z[bj][n] * inv * gv[bj][n];
                        if (fq == 0) {
#pragma unroll
                            for (int n = 0; n < 2; ++n) { const f32x4 cs = rcs[ai * 4 + m][n], sn = rsn[ai * 4 + m][n]; const f32x4 x1 = z[0][n], x2 = z[1][n]; z[0][n] = x1 * cs - x2 * sn; z[1][n] = x2 * cs + x1 * sn; }
                        }
                    }
                    float* po = nullptr;
                    if (kind > 0 && t >= TT - 128) po = out + oprompt + ((size_t)b * 128 + (t - (TT - 128))) * KVW + hcol;
#pragma unroll
                    for (int bj = 0; bj < 2; ++bj) {
                        v4u w; w.x = cvt_pk_bf16(z[bj][0][0], z[bj][0][1]); w.y = cvt_pk_bf16(z[bj][0][2], z[bj][0][3]); w.z = cvt_pk_bf16(z[bj][1][0], z[bj][1][1]); w.w = cvt_pk_bf16(z[bj][1][2], z[bj][1][3]);
                        *(v4u*)(dst + (size_t)r * ld + hcol + d0[bj]) = w;
                        if (po) { *(f32x4*)(po + d0[bj]) = z[bj][0]; *(f32x4*)(po + d0[bj] + 4) = z[bj][1]; }
                    }
                }
            }
        }
    }
};

__device__ __forceinline__ float wave_sum(float v) {
#pragma unroll
    for (int o = 1; o < 64; o <<= 1) v += __shfl_xor(v, o);
    return v;
}
template <bool HG>
__device__ __forceinline__ void transpose_item(const float* W, int N, const float* gain, bf16* WT, int ldt, int nrow0, int k0, int sc, LAS float* scr, int lane) {
#pragma unroll
    for (int i = 0; i < 32; ++i) { const int kk = 2 * i + (lane >> 5); float v = W[(size_t)(k0 + kk) * N + sc]; if (HG) v *= gain[k0 + kk]; scr[kk * 33 + (lane & 31)] = v; }
    LDS_WAIT(); asm volatile("" ::: "memory");
    const int c = lane & 7;
#pragma unroll
    for (int j = 0; j < 4; ++j) { const int n = (lane >> 3) + 8 * j; const LAS float* s = scr + (8 * c) * 33 + n;
        v4u o; o.x = cvt_pk_bf16(s[0 * 33], s[1 * 33]); o.y = cvt_pk_bf16(s[2 * 33], s[3 * 33]); o.z = cvt_pk_bf16(s[4 * 33], s[5 * 33]); o.w = cvt_pk_bf16(s[6 * 33], s[7 * 33]);
        *(v4u*)(WT + (size_t)(nrow0 + n) * ldt + k0 + 8 * c) = o; }
    LDS_WAIT(); asm volatile("" ::: "memory");
}
__device__ __forceinline__ int win_src(int np) {
    const int pn = np >> 8; if (pn < 2) return np;
    const int bj = (np >> 7) & 1, wc = (np >> 5) & 3, j = np & 31, dm = (j < 8) ? 8 * bj + j : 16 + 24 * bj + (j - 8);
    if (pn < 4) return 512 + 64 * (4 * (pn - 2) + wc) + dm;
    return (wc < 2) ? 1024 + 64 * wc + dm : 1152 + 64 * (wc - 2) + dm;
}
__device__ __forceinline__ int win_row(int pn, int wc, int d) {
    const int bj = (d < 8) ? 0 : (d < 16) ? 1 : (d < 40) ? 0 : 1, j = (d < 8) ? d : (d < 16) ? d - 8 : (d < 40) ? d - 8 : d - 32;
    return 256 * pn + 128 * bj + 32 * wc + j;
}

constexpr int SLAB_P = 33, SLAB_F = NTAIL * SLAB_P, SLAB_B = SLAB_F * 4;
constexpr int T_SLABS = 0, T_R0 = 4 * SLAB_B, T_R1 = 5 * SLAB_B, T_RS = 6 * SLAB_B;
static_assert(T_RS + NTAIL * 4 <= RING_BYTES, "tail LDS");
template <int K, int MT = 9>
__device__ __forceinline__ void skinny_pass(const bf16* A, const bf16* bp0, const bf16* bp1, LAS unsigned char* lds, int roff, int tid, int wave, int lane, int m0 = 0) {
    constexpr int KW = K / 8, NS = KW / 32;
    const int c = lane & 15, g = lane >> 4;
    const bf16* ap = A + (size_t)(16 * m0 + c) * K + wave * KW + 8 * g;     const bf16* b0 = bp0 + wave * KW + 8 * g; const bf16* b1 = bp1 + wave * KW + 8 * g;
    f32x4 acc[MT][2];
#pragma unroll
    for (int m = 0; m < MT; ++m) { acc[m][0] = (f32x4){0.f, 0.f, 0.f, 0.f}; acc[m][1] = (f32x4){0.f, 0.f, 0.f, 0.f}; }
    bf16x8 af[MT], bf0, bf1;
#pragma unroll
    for (int m = 0; m < MT; ++m) af[m] = *(const bf16x8*)(ap + (size_t)(16 * m) * K);
    bf0 = *(const bf16x8*)(b0); bf1 = *(const bf16x8*)(b1);
#pragma unroll (MT <= 3 ? 4 : 1)
    for (int ks = 0; ks < NS; ++ks) {
        const int kn = (ks + 1 < NS) ? ks + 1 : ks;
        bf16x8 an[MT];
#pragma unroll
        for (int m = 0; m < MT; ++m) an[m] = *(const bf16x8*)(ap + (size_t)(16 * m) * K + 32 * kn);
        const bf16x8 bn0 = *(const bf16x8*)(b0 + 32 * kn), bn1 = *(const bf16x8*)(b1 + 32 * kn);
#pragma unroll
        for (int m = 0; m < MT; ++m) { acc[m][0] = __builtin_amdgcn_mfma_f32_16x16x32_bf16(af[m], bf0, acc[m][0], 0, 0, 0); acc[m][1] = __builtin_amdgcn_mfma_f32_16x16x32_bf16(af[m], bf1, acc[m][1], 0, 0, 0); }
#pragma unroll
        for (int m = 0; m < MT; ++m) af[m] = an[m];
        bf0 = bn0; bf1 = bn1;
    }
    LAS float* sl = (LAS float*)(lds + T_SLABS) + (wave & 3) * SLAB_F + (4 * g) * SLAB_P + c;
    if (wave >= 4) {
#pragma unroll
        for (int m = 0; m < MT; ++m)
#pragma unroll
            for (int n = 0; n < 2; ++n)
#pragma unroll
                for (int e = 0; e < 4; ++e) sl[(16 * m + e) * SLAB_P + 16 * n] = acc[m][n][e];
    }
    __syncthreads();
    if (wave < 4) {
#pragma unroll
        for (int m = 0; m < MT; ++m)
#pragma unroll
            for (int n = 0; n < 2; ++n)
#pragma unroll
                for (int e = 0; e < 4; ++e) { const float v = acc[m][n][e] + sl[(16 * m + e) * SLAB_P + 16 * n]; sl[(16 * m + e) * SLAB_P + 16 * n] = v; }
    }
    __syncthreads();
    { const LAS float* s0 = (const LAS float*)(lds + T_SLABS); LAS float* R = (LAS float*)(lds + roff);
      for (int idx = tid; idx < 16 * MT * 32; idx += NTHR) { const int o = (idx >> 5) * SLAB_P + (idx & 31); R[o] = (s0[o] + s0[SLAB_F + o]) + (s0[2 * SLAB_F + o] + s0[3 * SLAB_F + o]); } }
    __syncthreads();
}
__device__ __forceinline__ void tail_rstd(const float* sst, LAS unsigned char* lds, int tid) {
    if (tid < NTAIL) { const f32x4* p = (const f32x4*)(sst + (size_t)tid * 32); f32x4 s = p[0];
#pragma unroll
        for (int i = 1; i < 8; ++i) s += p[i];
        ((LAS float*)(lds + T_RS))[tid] = __builtin_amdgcn_rsqf(((s.x + s.y) + (s.z + s.w)) * (1.0f / DM) + EPS); }
    __syncthreads();
}

constexpr int I_G = 16 * 88, I_IN = 16 * 40, I_OA = 8 * 32, I_OP = 1024, NITEMS = 6 * I_G + I_IN + I_OA + I_OP;
__device__ __forceinline__ void conv_item(int r, KArgs ka, LAS float* scr, int lane) {
    unsigned char* ws = ka->ws;
    bf16 *W1GU = (bf16*)(ws + WS_W1GU), *W1D = (bf16*)(ws + WS_W1D), *WIN = (bf16*)(ws + WS_WIN), *WOUT = (bf16*)(ws + WS_WOUT), *W2GU = (bf16*)(ws + WS_W2GU), *W2D = (bf16*)(ws + WS_W2D);
    if (r < 6 * I_G) {
        const int f = r / (3 * I_G); r -= f * 3 * I_G; const int which = r / I_G; r -= which * I_G;
        const float* gain = ka->in[f ? 18 : 6];
        if (which < 2) { const int kb = r / 88, nb = r % 88, n0 = 32 * nb; const float* W = ka->in[(f ? 19 : 7) + which];
            transpose_item<true>(W, DFF, gain, f ? W2GU : W1GU, DM, 256 * (n0 >> 7) + (n0 & 127) + 128 * which, 64 * kb, n0 + (lane & 31), scr, lane); }
        else { const int kb = r / 32, nb = r % 32; const float* W = ka->in[f ? 21 : 9];
            transpose_item<false>(W, DM, nullptr, f ? W2D : W1D, DFF, 32 * nb, 64 * kb, 32 * nb + (lane & 31), scr, lane); }
        return;
    }
    r -= 6 * I_G;
    if (r < I_IN) { const int kb = r / 40, nb = r % 40; transpose_item<true>(ka->in[11], NIN, ka->in[10], WIN, DM, 32 * nb, 64 * kb, win_src(32 * nb + (lane & 31)), scr, lane); return; }
    r -= I_IN;
    if (r < I_OA) { const int kb = r / 32, nb = r % 32; transpose_item<false>(ka->in[17] + (size_t)PW * DM, DM, nullptr, WOUT + PW, DM, 32 * nb, 64 * kb, 32 * nb + (lane & 31), scr, lane); return; }
    r -= I_OA;
    {
        const int g = r >> 8, ib = (r >> 4) & 15, nb = r & 15, n = 64 * nb + lane;
        const float* pw = ka->in[15] + ((size_t)g * 128 + 8 * ib) * 128; const float* psc = ka->in[16] + 128 * g; const float* wo = ka->in[17] + (size_t)(128 * g) * DM + n;
        float a[8];
#pragma unroll
        for (int ii = 0; ii < 8; ++ii) a[ii] = 0.f;
#pragma unroll 32
        for (int j = 0; j < 128; ++j) { const float wv = wo[(size_t)j * DM] * psc[j];
#pragma unroll
            for (int ii = 0; ii < 8; ++ii) a[ii] += pw[ii * 128 + j] * wv; }
        v4u o; o.x = cvt_pk_bf16(a[0], a[1]); o.y = cvt_pk_bf16(a[2], a[3]); o.z = cvt_pk_bf16(a[4], a[5]); o.w = cvt_pk_bf16(a[6], a[7]);
        *(v4u*)(WOUT + (size_t)n * DM + 128 * g + 8 * ib) = o;
    }
}

__global__ void __launch_bounds__(NTHR, 2) hymba_fwd(Args args) {
    extern __shared__ __attribute__((aligned(16))) unsigned char lds_raw[];
    LAS unsigned char* lds = (LAS unsigned char*)lds_raw;
    const int tid = threadIdx.x, lane = tid & 63, wave = __builtin_amdgcn_readfirstlane(tid >> 6);
    const int G = gridDim.x, bx = blockIdx.x, vcu = (G % 8 == 0) ? (bx % 8) * (G / 8) + bx / 8 : bx;
    unsigned char* ws = args.ws;
    const float *x_prompt = args.in[0], *x_sample = args.in[1], *state_pool = args.in[2], *cache_k = args.in[3], *cache_v = args.in[4], *meta = args.in[5];
    float* out = args.out;
    float* SS = (float*)(ws + WS_SS); float* SST = (float*)(ws + WS_SST); float* ROPE = (float*)(ws + WS_ROPE);
    bf16 *W1GU = (bf16*)(ws + WS_W1GU), *W1D = (bf16*)(ws + WS_W1D), *WIN = (bf16*)(ws + WS_WIN), *WOUT = (bf16*)(ws + WS_WOUT), *W2GU = (bf16*)(ws + WS_W2GU), *W2D = (bf16*)(ws + WS_W2D);
    bf16 *XB = (bf16*)(ws + WS_XB), *ACT = (bf16*)(ws + WS_ACT), *Ub = (bf16*)(ws + WS_U), *Qb = (bf16*)(ws + WS_Q), *Kb = (bf16*)(ws + WS_K), *Vb = (bf16*)(ws + WS_V), *MIX = (bf16*)(ws + WS_MIX);
    const int lo = args.ph_lo, hi = args.ph_hi;
#define IN(k) (lo <= (k) && (k) < hi)
#define SEAM(k) do { if (IN(k) && IN((k) + 1)) { xcd_barrier(xbar); } } while (0)
    volatile LAS unsigned* xst = (volatile LAS unsigned*)(lds + RING_BYTES + 256);
    if (tid == 0) { xst[0] = 0u; xst[1] = 0u; }
    __syncthreads();
    XcdBarrier xbar; xbar.bar = (unsigned*)(ws + WS_CTL) + 4096; xbar.x = 0; xbar.st = nullptr;
    if (hi - lo > 1) xbar = xcd_barrier_post((unsigned*)(ws + WS_CTL) + 4096, xst);
    if (hi > 64) cg::this_grid().sync();

    LAS float* RST = (LAS float*)(lds + RING_BYTES + 1024);
#define BUILD_RST(S_) do { const int nU_ = ((S_).nwg - (S_).c + (S_).G - 1) / (S_).G, ntab_ = nU_ * 256; \
        for (int base_ = 0; base_ < ntab_; base_ += 4 * NTHR) { f32x4 p_[4][4]; \
            _Pragma("unroll") for (int e_ = 0; e_ < 4; ++e_) { int idx_ = base_ + tid + NTHR * e_; idx_ = idx_ < ntab_ ? idx_ : ntab_ - 1; pg8::Unit uu_; (S_).next(idx_ >> 8, uu_); \
                const f32x4* q_ = (const f32x4*)(SS + ((size_t)uu_.pm * 256 + (idx_ & 255)) * 16); p_[e_][0] = q_[0]; p_[e_][1] = q_[1]; p_[e_][2] = q_[2]; p_[e_][3] = q_[3]; } \
            _Pragma("unroll") for (int e_ = 0; e_ < 4; ++e_) { const int idx_ = base_ + tid + NTHR * e_; const f32x4 s_ = (p_[e_][0] + p_[e_][1]) + (p_[e_][2] + p_[e_][3]); \
                if (idx_ < ntab_) RST[idx_] = __builtin_amdgcn_rsqf(((s_.x + s_.y) + (s_.z + s_.w)) * (1.0f / DM) + EPS); } } \
        __syncthreads(); } while (0)
#define TAIL_SWIGLU(WGU, sst) do { tail_rstd((sst), lds, tid); \
        for (int su = bx; su < DFF / 16; su += G) { const int n0 = 16 * su, gr = 256 * (n0 >> 7) + (n0 & 127) + (lane & 15); \
            skinny_pass<DM>(XB + (size_t)TAIL0 * DM, (WGU) + (size_t)gr * DM, (WGU) + (size_t)(gr + 128) * DM, lds, T_R0, tid, wave, lane); \
            const LAS float* R = (const LAS float*)(lds + T_R0); const LAS float* RS = (const LAS float*)(lds + T_RS); \
            for (int idx = tid; idx < NTAIL * 16; idx += NTHR) { const int row = idx >> 4, col = idx & 15; const float rs = RS[row]; \
                ACT[(size_t)(TAIL0 + row) * DFF + n0 + col] = (bf16)(cvt_pk_bf16(silu_mul(R[row * SLAB_P + col] * rs, R[row * SLAB_P + 16 + col] * rs), 0.f) & 0xffffu); } \
            __syncthreads(); } } while (0)
#define TAIL_RES(MODE, KK, Aten, WT, sst_out) do { \
        for (int su = bx; su < 3 * (DM / 32); su += G) { const int cb = su / 3, mg = su - 3 * cb, n0 = 32 * cb, m0 = 3 * mg;     \
            skinny_pass<KK, 3>((Aten) + (size_t)TAIL0 * (KK), (WT) + (size_t)(n0 + (lane & 15)) * (KK), (WT) + (size_t)(n0 + 16 + (lane & 15)) * (KK), lds, T_R0, tid, wave, lane, m0); \
            const LAS float* R = (const LAS float*)(lds + T_R0); \
            for (int idx = tid; idx < 48 * 32; idx += NTHR) { const int rrel = idx >> 5, row = 16 * m0 + rrel, col = idx & 31; const size_t xo = (size_t)(TAIL0 + row) * DM + n0 + col; \
                const float v = bf2f(XB[xo]) + (((MODE) == 1) ? 1.0f : 0.5f) * R[rrel * SLAB_P + col]; \
                if ((MODE) < 2) { XB[xo] = (bf16)(cvt_pk_bf16(v, 0.f) & 0xffffu); float ss = v * v; ss += __shfl_xor(ss, 1); ss += __shfl_xor(ss, 2); ss += __shfl_xor(ss, 4); ss += __shfl_xor(ss, 8); ss += __shfl_xor(ss, 16); \
                    if (col == 0) (sst_out)[(size_t)row * 32 + cb] = ss; } \
                else if (row >= NMETA) out[O_YS + (size_t)(row - NMETA) * DM + n0 + col] = v; } \
            __syncthreads(); } } while (0)

    if (IN(0)) {
        LAS float* scr = (LAS float*)(lds + wave * 16384);
        const int gw = vcu * NWAVES + wave, NGW = G * NWAVES;
        { const KArgs ka = (KArgs)__builtin_amdgcn_kernarg_segment_ptr();
          for (int it = gw; it < 3 * I_G + I_IN; it += NGW) conv_item(it < 3 * I_G ? it : it + 3 * I_G, ka, scr, lane); }
        for (int r4 = gw; r4 < (MAIN + NTAIL) / 4; r4 += NGW) {
            f32x4 v[4][4];
#pragma unroll
            for (int rr = 0; rr < 4; ++rr) { const int r = 4 * r4 + rr; const float* src = (r < MAIN) ? x_prompt + (size_t)r * DM : (r < MAIN + NMETA) ? meta + (size_t)(r - MAIN) * DM : x_sample + (size_t)(r - MAIN - NMETA) * DM;
#pragma unroll
                for (int j = 0; j < 4; ++j) v[rr][j] = ((const f32x4*)src)[lane + 64 * j]; }
#pragma unroll
            for (int rr = 0; rr < 4; ++rr) { const int r = 4 * r4 + rr; float s = 0.f;
#pragma unroll
                for (int j = 0; j < 4; ++j) s += (v[rr][j].x * v[rr][j].x + v[rr][j].y * v[rr][j].y) + (v[rr][j].z * v[rr][j].z + v[rr][j].w * v[rr][j].w);
                s = wave_sum(s);
#pragma unroll
                for (int j = 0; j < 4; ++j) { v2u w; w.x = cvt_pk_bf16(v[rr][j].x, v[rr][j].y); w.y = cvt_pk_bf16(v[rr][j].z, v[rr][j].w); ((v2u*)(XB + (size_t)r * DM))[lane + 64 * j] = w; }
                if (r < MAIN) { if (lane < 16) SS[(size_t)r * 16 + lane] = (lane == 0) ? s : 0.f; } else if (lane < 32) SST[(size_t)(r - MAIN) * 32 + lane] = (lane == 0) ? s : 0.f; }
        }
        const int gt = vcu * NTHR + tid, NGT = G * NTHR;
        for (int i = gt; i < NPOS * 8; i += NGT) {
            const int p = i >> 3, f = i & 7; const float pos = (p < TT) ? (float)p : (float)PASTLEN; const float ang = pos * args.invf[f];
            const double xd = (double)ang, nn = __builtin_rint(xd * 0.15915494309189535), rr = __builtin_fma(-nn, 6.283185307179586, xd), r2 = rr * rr;
            double c = 1.0, s = rr, tc = 1.0, ts = rr;
#pragma unroll
            for (int k = 1; k <= 15; ++k) { tc *= -r2 * (1.0 / (double)((2 * k - 1) * (2 * k))); c += tc; ts *= -r2 * (1.0 / (double)((2 * k) * (2 * k + 1))); s += ts; }
            ROPE[(size_t)p * 16 + f] = (float)c; ROPE[(size_t)p * 16 + 8 + f] = (float)s;
        }
    }
    SEAM(0);
    if (IN(1)) { TAIL_SWIGLU(W1GU, SST);
        { pg8::Gemm g{XB, W1GU, MAIN, NGU, DM}; pg8::StaticOrder S; S.init(MAIN, NGU, G, bx); BUILD_RST(S); EpiSwiGLU E{RST};
        pg8::gemm_phase<EpiSwiGLU, pg8::StaticOrder, true, true, DM>(lds, g, S, E); }  }
    SEAM(1);
    if (IN(2)) { TAIL_RES(0, DFF, ACT, W1D, SST + NTAIL * 32);
        { pg8::Gemm g{ACT, W1D, MAIN, DM, DFF}; pg8::StaticOrder S; S.init(MAIN, DM, G, bx); EpiRes<0> E{};
        pg8::gemm_phase<EpiRes<0>, pg8::StaticOrder, true, true, DFF, true>(lds, g, S, E); }  }
    SEAM(2);
    if (IN(3)) {
        if (bx >= G / 2) {
            LAS float* scr = (LAS float*)(lds + wave * 16384); const int hw = (bx - G / 2) * NWAVES + wave, NHW = (G - G / 2) * NWAVES;
            const KArgs ka = (KArgs)__builtin_amdgcn_kernarg_segment_ptr();
            for (int it = hw; it < 3 * I_G + I_OA + I_OP; it += NHW) conv_item(it < 3 * I_G ? it + 3 * I_G : it + 3 * I_G + I_IN, ka, scr, lane);
            const int ht = (bx - G / 2) * NTHR + tid, NHT = (G - G / 2) * NTHR;
            for (int i = ht; i < DB * 14 * (PW / 4); i += NHT) { const int q = i / (14 * (PW / 4)), rem = i - q * (14 * (PW / 4)); ((f32x4*)(out + O_PS))[(size_t)q * 15 * (PW / 4) + rem] = ((const f32x4*)state_pool)[(size_t)q * 15 * (PW / 4) + (PW / 4) + rem]; }
            for (int i0 = ht; i0 < DB * 127 * (KVW / 4); i0 += 4 * NHT) { f32x4 kk[4], vv[4]; size_t dd[4];
#pragma unroll
                for (int u = 0; u < 4; ++u) { int i = i0 + u * NHT; i = i < DB * 127 * (KVW / 4) ? i : DB * 127 * (KVW / 4) - 1; const int q = i / (127 * (KVW / 4)), rem = i - q * (127 * (KVW / 4)); dd[u] = (size_t)q * 128 * (KVW / 4) + rem;
                    kk[u] = ((const f32x4*)cache_k)[dd[u] + (KVW / 4)]; vv[u] = ((const f32x4*)cache_v)[dd[u] + (KVW / 4)]; }
#pragma unroll
                for (int u = 0; u < 4; ++u) { ((f32x4*)(out + O_KS))[dd[u]] = kk[u]; ((f32x4*)(out + O_VS))[dd[u]] = vv[u]; } }
            __syncthreads();
        }
        tail_rstd(SST + NTAIL * 32, lds, tid);
        for (int s3 = (bx >= G / 2) ? bx - G / 2 : 60; s3 < 60; s3 += G / 2) { const int su = s3 / 3, m0 = 3 * (s3 - 3 * su);
            const int kind = (su < 8) ? 3 : (su < 16) ? 0 : (su < 18) ? 1 : 2;
            const int hh = (kind == 3) ? su : (kind == 0) ? su - 8 : (kind == 1) ? su - 16 : su - 18;
            const int pn = (kind == 3) ? (hh >> 2) : (kind == 0) ? 2 + (hh >> 2) : 4, wc = (kind == 3) ? 0 : (kind == 0) ? (hh & 3) : (kind == 1) ? hh : 2 + hh;
#pragma unroll
            for (int p = 0; p < 2; ++p) { const int d0 = 32 * p + (lane & 15);
                const int r0 = (kind == 3) ? 64 * hh + d0 : win_row(pn, wc, d0), r1 = (kind == 3) ? 64 * hh + d0 + 16 : win_row(pn, wc, d0 + 16);
                skinny_pass<DM, 3>(XB + (size_t)TAIL0 * DM, WIN + (size_t)r0 * DM, WIN + (size_t)r1 * DM, lds, p ? T_R1 : T_R0, tid, wave, lane, m0); }
            const LAS float* RS = (const LAS float*)(lds + T_RS); const int d = lane; const LAS float* R = (const LAS float*)(lds + ((d < 32) ? T_R0 : T_R1)) + (d & 31);
            const float gain = (kind == 0) ? args.in[12][d] : (kind == 1) ? args.in[13][d] : 1.0f;
            for (int rrel = wave; rrel < 48; rrel += NWAVES) { const int row = 16 * m0 + rrel;
                float v = R[rrel * SLAB_P] * RS[row]; const size_t tr = (size_t)TAIL0 + row;
                if (kind == 3) { Ub[tr * PW + 64 * hh + d] = (bf16)(cvt_pk_bf16(v, 0.f) & 0xffffu); if (row >= NMETA) out[O_PS + ((size_t)(row - NMETA) * 15 + 14) * PW + 64 * hh + d] = v; }
                else {
                    if (kind < 2) { const float ssq = wave_sum(v * v); v = v * __builtin_amdgcn_rsqf(ssq * (1.0f / HD) + EPS) * gain;
                        const float pr = __shfl_xor(v, 8); const float* rp = ROPE + (size_t)((row < NMETA) ? row : TT) * 16 + (d & 7); const float cs = rp[0], sn = rp[8];
                        if (d < 8) v = v * cs - pr * sn; else if (d < 16) v = v * cs + pr * sn; }
                    if (kind == 0) Qb[tr * PW + 64 * hh + d] = (bf16)(cvt_pk_bf16(v, 0.f) & 0xffffu);
                    else { bf16* dstp = (kind == 1) ? Kb : Vb; dstp[tr * KVW + 64 * hh + d] = (bf16)(cvt_pk_bf16(v, 0.f) & 0xffffu);
                        if (row >= NMETA) out[((kind == 1) ? O_KS : O_VS) + ((size_t)(row - NMETA) * 128 + 127) * KVW + 64 * hh + d] = v; }
                }
            }
            __syncthreads();
        }
        { pg8::Gemm g{XB, WIN, MAIN, NIN, DM}; pg8::StaticOrder S; S.init(MAIN, NIN, G, bx); BUILD_RST(S); EpiIn E{RST};
        pg8::gemm_phase<EpiIn, pg8::StaticOrder, true, true, DM>(lds, g, S, E); } }
    SEAM(3);
    if (IN(4)) {
        constexpr int KPITCH = 144, KROWS = 192, KS_BYTES = 2 * KROWS * KPITCH, VS_OFF = KS_BYTES, PB_OFF = 2 * KS_BYTES;
        static_assert(PB_OFF <= RING_BYTES, "attention LDS");
        const float* sinks = args.in[14];
        constexpr int NPU = NB * 32;
        for (int ui0 = vcu; ui0 < NPU; ui0 += G) {
            const int ui = (G == 256) ? (((2 * (bx & 7) + (ui0 >> 8)) << 5) + (bx >> 3)) : ui0;
            const int b = ui >> 5, blk = ui & 31, t0 = 64 * blk + NMETA; const size_t rb = (size_t)b * SEQ;
            v4u kreg[6], vreg[6];
#pragma unroll
            for (int it = 0; it < 6; ++it) { const int ch = tid + it * NTHR, kk = ch >> 4, c16 = ch & 15; int p = t0 - 128 + kk; p = p < 0 ? 0 : p; const size_t row = (p >= NMETA) ? rb + (p - NMETA) : (size_t)TAIL0 + p;
                kreg[it] = *(const v4u*)(Kb + row * KVW + c16 * 8); vreg[it] = *(const v4u*)(Vb + row * KVW + c16 * 8); }
            unsigned xr[48];
            const int cp = tid & 255, rh = tid >> 8;
#pragma unroll
            for (int ii = 0; ii < 48; ++ii) { const int p = t0 + 32 * rh - 16 + ii; const size_t row = (p >= NMETA) ? rb + (p - NMETA) : (size_t)TAIL0 + p; xr[ii] = *(const unsigned*)(Ub + row * PW + 2 * cp); }
            const int h = wave, kvh = h >> 2, q = lane & 15, g = lane >> 4;
            bf16x8 qf[4][2];
#pragma unroll
            for (int j = 0; j < 4; ++j) { const bf16* qp = Qb + (rb + (t0 - NMETA) + 16 * j + q) * PW + 64 * h + 8 * g; qf[j][0] = *(const bf16x8*)(qp); qf[j][1] = *(const bf16x8*)(qp + 32); }
            { float xa[48], xb[48];
#pragma unroll
              for (int ii = 0; ii < 48; ++ii) { xa[ii] = __uint_as_float(xr[ii] << 16); xb[ii] = __uint_as_float(xr[ii] & 0xffff0000u); }
              bf16* mp = MIX + (rb + (t0 - NMETA) + 32 * rh) * DM + 2 * cp; const int wsel = cp >> 6;
#define POOL_W(W) { float Sa = 0.f, Sb = 0.f; _Pragma("unroll") for (int i = 16 - (W); i < 16; ++i) { Sa += xa[i]; Sb += xb[i]; } \
                _Pragma("unroll") for (int tt = 0; tt < 32; ++tt) { Sa += xa[16 + tt] - xa[16 + tt - (W)]; Sb += xb[16 + tt] - xb[16 + tt - (W)]; \
                    *(unsigned*)(mp + (size_t)tt * DM) = cvt_pk_bf16(Sa * (1.0f / (float)(W)) - xa[16 + tt], Sb * (1.0f / (float)(W)) - xb[16 + tt]); } }
              if (wsel == 0) POOL_W(2) else if (wsel == 1) POOL_W(4) else if (wsel == 2) POOL_W(8) else POOL_W(16)
#undef POOL_W
            }
#pragma unroll
            for (int it = 0; it < 6; ++it) { const int ch = tid + it * NTHR, kk = ch >> 4, c16 = ch & 15, kv = c16 >> 3, c8 = c16 & 7; const bool ok = (t0 - 128 + kk) >= 0;
                const v4u z4 = (v4u){0u, 0u, 0u, 0u}; const int off = (kv * KROWS + kk) * KPITCH + c8 * 16;
                *(LAS v4u*)(lds + off) = ok ? kreg[it] : z4; *(LAS v4u*)(lds + VS_OFF + off) = ok ? vreg[it] : z4; }
            __syncthreads();
            { const float sink = sinks[h] * 1.4426950408889634f;
              const LAS unsigned char* ksb = lds + (kvh * KROWS) * KPITCH; const LAS unsigned char* vsb = lds + VS_OFF + (kvh * KROWS) * KPITCH + (4 * g + ((lane >> 2) & 3)) * KPITCH + (lane & 3) * 8;
#pragma unroll
              for (int jp = 0; jp < 2; ++jp) {
                  f32x4 s[2][9]; float mx[2], l[2], rden[2];
#pragma unroll
                  for (int kt = 0; kt < 9; ++kt)
#pragma unroll
                      for (int jj = 0; jj < 2; ++jj) { const int j = 2 * jp + jj; const LAS unsigned char* kp = ksb + (16 * (j + kt) + q) * KPITCH + 16 * g;
                          const bf16x8 k0 = *(const LAS bf16x8*)(kp), k1 = *(const LAS bf16x8*)(kp + 64);
                          f32x4 a = (f32x4){0.f, 0.f, 0.f, 0.f}; a = __builtin_amdgcn_mfma_f32_16x16x32_bf16(k0, qf[j][0], a, 0, 0, 0); a = __builtin_amdgcn_mfma_f32_16x16x32_bf16(k1, qf[j][1], a, 0, 0, 0); s[jj][kt] = a; }
#pragma unroll
                  for (int jj = 0; jj < 2; ++jj) { const int tq0 = t0 + 16 * (2 * jp + jj), qpos = tq0 + q; float mxx = -1e30f;
#pragma unroll
                      for (int kt = 0; kt < 9; ++kt)
#pragma unroll
                          for (int e = 0; e < 4; ++e) { const int kp = tq0 - 128 + 16 * kt + 4 * g + e; const bool ok = (kp >= 0) && (kp <= qpos) && (kp > qpos - 128); const float v = ok ? s[jj][kt][e] * (0.125f * 1.4426950408889634f) : -1e30f; s[jj][kt][e] = v; mxx = fmaxf(mxx, v); }
                      mx[jj] = mxx; }
#pragma unroll
                  for (int jj = 0; jj < 2; ++jj) mx[jj] = fmaxf(mx[jj], __shfl_xor(mx[jj], 16));
#pragma unroll
                  for (int jj = 0; jj < 2; ++jj) mx[jj] = fmaxf(fmaxf(mx[jj], __shfl_xor(mx[jj], 32)), sink);
#pragma unroll
                  for (int jj = 0; jj < 2; ++jj) { float ll = 0.f;
#pragma unroll
                      for (int kt = 0; kt < 9; ++kt)
#pragma unroll
                          for (int e = 0; e < 4; ++e) { const float p = __builtin_amdgcn_exp2f(s[jj][kt][e] - mx[jj]); s[jj][kt][e] = p; ll += p; }
                      l[jj] = ll; }
#pragma unroll
                  for (int jj = 0; jj < 2; ++jj) l[jj] += __shfl_xor(l[jj], 16);
#pragma unroll
                  for (int jj = 0; jj < 2; ++jj) { l[jj] += __shfl_xor(l[jj], 32); rden[jj] = __builtin_amdgcn_rcpf(l[jj] + __builtin_amdgcn_exp2f(sink - mx[jj])); }
                  f32x4 o[2][4];
#pragma unroll
                  for (int jj = 0; jj < 2; ++jj)
#pragma unroll
                      for (int dt = 0; dt < 4; ++dt) o[jj][dt] = (f32x4){0.f, 0.f, 0.f, 0.f};
#pragma unroll
                  for (int s2 = 0; s2 < 5; ++s2)
#pragma unroll
                      for (int jj = 0; jj < 2; ++jj) { const int j = 2 * jp + jj;
                          v4u pw; pw.x = cvt_pk_bf16(s[jj][2 * s2][0], s[jj][2 * s2][1]); pw.y = cvt_pk_bf16(s[jj][2 * s2][2], s[jj][2 * s2][3]);
                          if (s2 < 4) { pw.z = cvt_pk_bf16(s[jj][2 * s2 + 1][0], s[jj][2 * s2 + 1][1]); pw.w = cvt_pk_bf16(s[jj][2 * s2 + 1][2], s[jj][2 * s2 + 1][3]); } else { pw.z = 0u; pw.w = 0u; }
                          const bf16x8 pf = __builtin_bit_cast(bf16x8, pw);
#pragma unroll
                          for (int dt = 0; dt < 4; ++dt) { const LAS unsigned char* vp = vsb + (16 * (j + 2 * s2)) * KPITCH + dt * 32;
                              const s16x4 va = vtr(vp), vb = vtr(vp + ((s2 < 4) ? 16 * KPITCH : 0)); const bf16x8 vf = (bf16x8){va[0], va[1], va[2], va[3], vb[0], vb[1], vb[2], vb[3]};
                              o[jj][dt] = __builtin_amdgcn_mfma_f32_16x16x32_bf16(vf, pf, o[jj][dt], 0, 0, 0); } }
#pragma unroll
                  for (int jj = 0; jj < 2; ++jj) { bf16* op = MIX + (rb + (t0 + 16 * (2 * jp + jj) - NMETA) + q) * DM + PW + 64 * h + 4 * g;
#pragma unroll
                      for (int dt = 0; dt < 4; ++dt) { v2u w; w.x = cvt_pk_bf16(o[jj][dt][0] * rden[jj], o[jj][dt][1] * rden[jj]); w.y = cvt_pk_bf16(o[jj][dt][2] * rden[jj], o[jj][dt][3] * rden[jj]); *(v2u*)(op + 16 * dt) = w; } }
              } }
            __syncthreads();
        }
        for (int su = vcu; su < 2 * DB; su += G) {
            const int i = su >> 1, kv = su & 1; const size_t r = (size_t)TAIL0 + NMETA + i;
            f32x4 kr4[4], vr4[4];
#pragma unroll
            for (int it = 0; it < 4; ++it) { int ch = tid + it * NTHR; ch = ch < 2032 ? ch : 2031; const int row = ch >> 4, c = ch & 15; const size_t off = ((size_t)i * 128 + row + 1) * KVW + 64 * kv + 4 * c;
                kr4[it] = *(const f32x4*)(cache_k + off); vr4[it] = *(const f32x4*)(cache_v + off); }
            v4u knew = (v4u){0u, 0u, 0u, 0u}, vnew = (v4u){0u, 0u, 0u, 0u};
            if (tid < 8) { knew = *(const v4u*)(Kb + r * KVW + 64 * kv + 8 * tid); vnew = *(const v4u*)(Vb + r * KVW + 64 * kv + 8 * tid); }
            if (kv == 0) {
                const int c = tid, w = 2 << (c >> 7); const float cur = bf2f(Ub[r * PW + c]); const float* sp = state_pool + (size_t)i * 15 * PW + c; float xs[15];
#pragma unroll
                for (int k = 0; k < 15; ++k) xs[k] = sp[(size_t)k * PW];
                float S = cur;
#pragma unroll
                for (int k = 0; k < 15; ++k) S += (k >= 16 - w) ? xs[k] : 0.f;
                const float d = S / (float)w - cur; MIX[r * DM + c] = (bf16)(cvt_pk_bf16(d, 0.f) & 0xffffu);
            }
#pragma unroll
            for (int it = 0; it < 4; ++it) { const int ch = tid + it * NTHR; if (ch < 2032) { const int row = ch >> 4, c = ch & 15, off = row * KPITCH + c * 8;
                v2u a; a.x = cvt_pk_bf16(kr4[it].x, kr4[it].y); a.y = cvt_pk_bf16(kr4[it].z, kr4[it].w); *(LAS v2u*)(lds + off) = a;
                v2u bq; bq.x = cvt_pk_bf16(vr4[it].x, vr4[it].y); bq.y = cvt_pk_bf16(vr4[it].z, vr4[it].w); *(LAS v2u*)(lds + VS_OFF + off) = bq; } }
            if (tid < 8) { *(LAS v4u*)(lds + 127 * KPITCH + tid * 16) = knew; *(LAS v4u*)(lds + VS_OFF + 127 * KPITCH + tid * 16) = vnew; }
            __syncthreads();
            if (wave == 0) {
                const int q = lane & 15, g = lane >> 4, hq = 4 * kv + (q & 3); const float sink = sinks[hq] * 1.4426950408889634f;
                const bf16* qp = Qb + r * PW + 64 * hq + 8 * g; const bf16x8 qf0 = *(const bf16x8*)(qp), qf1 = *(const bf16x8*)(qp + 32);
                const LAS unsigned char* vsb = lds + VS_OFF + (4 * g + ((lane >> 2) & 3)) * KPITCH + (lane & 3) * 8;
                f32x4 s[8]; float mx = -1e30f;
#pragma unroll
                for (int kt = 0; kt < 8; ++kt) { const LAS unsigned char* kp = lds + (16 * kt + q) * KPITCH + 16 * g;
                    const bf16x8 k0 = *(const LAS bf16x8*)(kp), k1 = *(const LAS bf16x8*)(kp + 64);
                    f32x4 a = (f32x4){0.f, 0.f, 0.f, 0.f}; a = __builtin_amdgcn_mfma_f32_16x16x32_bf16(k0, qf0, a, 0, 0, 0); a = __builtin_amdgcn_mfma_f32_16x16x32_bf16(k1, qf1, a, 0, 0, 0);
                    a = a * (0.125f * 1.4426950408889634f); s[kt] = a; mx = fmaxf(fmaxf(mx, fmaxf(a[0], a[1])), fmaxf(a[2], a[3])); }
                mx = fmaxf(mx, __shfl_xor(mx, 16)); mx = fmaxf(mx, __shfl_xor(mx, 32)); mx = fmaxf(mx, sink);
                float l = 0.f;
#pragma unroll
                for (int kt = 0; kt < 8; ++kt)
#pragma unroll
                    for (int e = 0; e < 4; ++e) { const float p = __builtin_amdgcn_exp2f(s[kt][e] - mx); s[kt][e] = p; l += p; }
                l += __shfl_xor(l, 16); l += __shfl_xor(l, 32);
                const float rden = __builtin_amdgcn_rcpf(l + __builtin_amdgcn_exp2f(sink - mx));
                f32x4 o[4];
#pragma unroll
                for (int dt = 0; dt < 4; ++dt) o[dt] = (f32x4){0.f, 0.f, 0.f, 0.f};
#pragma unroll
                for (int s2 = 0; s2 < 4; ++s2) {
                    v4u pw; pw.x = cvt_pk_bf16(s[2 * s2][0], s[2 * s2][1]); pw.y = cvt_pk_bf16(s[2 * s2][2], s[2 * s2][3]); pw.z = cvt_pk_bf16(s[2 * s2 + 1][0], s[2 * s2 + 1][1]); pw.w = cvt_pk_bf16(s[2 * s2 + 1][2], s[2 * s2 + 1][3]);
                    const bf16x8 pf = __builtin_bit_cast(bf16x8, pw);
#pragma unroll
                    for (int dt = 0; dt < 4; ++dt) { const LAS unsigned char* vp = vsb + (32 * s2) * KPITCH + dt * 32;
                        const s16x4 va = vtr(vp), vb = vtr(vp + 16 * KPITCH); const bf16x8 vf = (bf16x8){va[0], va[1], va[2], va[3], vb[0], vb[1], vb[2], vb[3]};
                        o[dt] = __builtin_amdgcn_mfma_f32_16x16x32_bf16(vf, pf, o[dt], 0, 0, 0); }
                }
                if (q < 4) { bf16* op = MIX + r * DM + PW + 64 * hq + 4 * g;
#pragma unroll
                    for (int dt = 0; dt < 4; ++dt) { v2u w; w.x = cvt_pk_bf16(o[dt][0] * rden, o[dt][1] * rden); w.y = cvt_pk_bf16(o[dt][2] * rden, o[dt][3] * rden); *(v2u*)(op + 16 * dt) = w; } }
            }
            __syncthreads();
        }
        for (int i = vcu * NTHR + tid; i < NMETA * (DM / 8); i += G * NTHR) ((v4u*)(MIX + (size_t)TAIL0 * DM))[i] = (v4u){0u, 0u, 0u, 0u};
    }
    SEAM(4);
    if (IN(5)) { TAIL_RES(1, DM, MIX, WOUT, SST + 2 * NTAIL * 32);
        { pg8::Gemm g{MIX, WOUT, MAIN, DM, DM}; pg8::StaticOrder S; S.init(MAIN, DM, G, bx); EpiRes<1> E{};
        pg8::gemm_phase<EpiRes<1>, pg8::StaticOrder, true, true, DM>(lds, g, S, E); }  }
    SEAM(5);
    if (IN(6)) { TAIL_SWIGLU(W2GU, SST + 2 * NTAIL * 32);
        { pg8::Gemm g{XB, W2GU, MAIN, NGU, DM}; pg8::StaticOrder S; S.init(MAIN, NGU, G, bx); BUILD_RST(S); EpiSwiGLU E{RST};
        pg8::gemm_phase<EpiSwiGLU, pg8::StaticOrder, true, true, DM>(lds, g, S, E); }  }
    SEAM(6);
    if (IN(7)) { TAIL_RES(2, DFF, ACT, W2D, SST);
        { pg8::Gemm g{ACT, W2D, MAIN, DM, DFF}; pg8::StaticOrder S; S.init(MAIN, DM, G, bx); EpiRes<2> E{};
        pg8::gemm_phase<EpiRes<2>, pg8::StaticOrder, true, true, DFF, true>(lds, g, S, E); }  }
#undef IN
#undef SEAM
}

extern "C" void kernel_launch(void* const* d_in, const int* in_sizes, int n_in, void* d_out, int out_size, void* d_ws, size_t ws_size, hipStream_t stream) {
    static int grid = 0;
    if (grid == 0) {
        if (n_in != 22 || (size_t)out_size != O_END || ws_size < WS_END) { fprintf(stderr, "kernel_launch: unexpected shapes: n_in %d out %d ws %zu (need %zu)\n", n_in, out_size, ws_size, (size_t)WS_END); grid = -1; return; }
        int dev = 0, cus = 0, per_cu = 0;
        if (hipGetDevice(&dev) != hipSuccess || hipDeviceGetAttribute(&cus, hipDeviceAttributeMultiprocessorCount, dev) != hipSuccess) { grid = -1; return; }
        if (hipFuncSetAttribute((const void*)hymba_fwd, hipFuncAttributeMaxDynamicSharedMemorySize, LDS_BYTES) != hipSuccess) { fprintf(stderr, "kernel_launch: hipFuncSetAttribute failed\n"); grid = -1; return; }
        if (hipOccupancyMaxActiveBlocksPerMultiprocessor(&per_cu, (const void*)hymba_fwd, NTHR, LDS_BYTES) != hipSuccess || per_cu < 1) { fprintf(stderr, "kernel_launch: occupancy query says %d\n", per_cu); per_cu = 1; }
        (void)hipGetLastError();
        grid = cus * 1;
    }
    if (grid < 0) return;
    if (hipMemsetAsync((char*)d_ws + WS_CTL, 0, 65536, stream) != hipSuccess) { fprintf(stderr, "kernel_launch: memset failed\n"); return; }
    Args a{};
    for (int i = 0; i < 22; ++i) a.in[i] = (const float*)d_in[i];
    a.out = (float*)d_out; a.ws = (unsigned char*)d_ws;
    for (int i = 0; i < 8; ++i) { const float e = (float)(-13.122363377404328) * (float)i * 0.125f; a.invf[i] = (float)std::exp((double)e); }
#if MK_N_LAUNCHES == 1
    a.ph_lo = 0; a.ph_hi = 8;
    void* kargs[] = {&a};
    const hipError_t e = hipLaunchCooperativeKernel((const void*)hymba_fwd, dim3(grid), dim3(NTHR), kargs, LDS_BYTES, stream);
    if (e != hipSuccess) fprintf(stderr, "kernel_launch: cooperative launch failed: %s (grid %d)\n", hipGetErrorString(e), grid);
#ifdef PROBE_PHASE
    a.ph_lo = PROBE_PHASE; a.ph_hi = PROBE_PHASE + 1; hipLaunchKernelGGL(hymba_fwd, dim3(grid), dim3(NTHR), LDS_BYTES, stream, a);
#endif
#else
    for (int p = 0; p < 8; ++p) { a.ph_lo = p; a.ph_hi = p + 1; hipLaunchKernelGGL(hymba_fwd, dim3(grid), dim3(NTHR), LDS_BYTES, stream, a); }
#endif
}
```

```cpp
#include <hip/hip_runtime.h>
#include <hip/hip_cooperative_groups.h>
#include <cstdio>
#include <cstdint>
#include <cmath>
namespace cg = cooperative_groups;
namespace pg8 {
#define PG8_LAS __attribute__((address_space(3)))
typedef unsigned short bf16_t;
typedef short bf16x8 __attribute__((ext_vector_type(8)));
typedef float f32x4 __attribute__((ext_vector_type(4)));
typedef unsigned u32x4 __attribute__((ext_vector_type(4)));
constexpr int BM = 256, BK = 64, HALF = 128, HTB = HALF * BK * 2  , STAGE_BYTES = 8 * HTB, NXCD = 8, WGM = 4;

__host__ __device__ __forceinline__ int lds_byte(int r, int c) { const int st = (r >> 4) * 2 + (c >> 5), rr = r & 15, cc = c & 31, ob = rr * 64 + cc * 2; return st * 1024 + (ob ^ (((ob >> 9) & 1) << 5)); }
__host__ __device__ __forceinline__ void stage_rc(int b, int& R, int& C) { const int st = b / 1024, sb = b % 1024, swz = sb ^ (((sb >> 9) & 1) << 5); R = (st >> 1) * 16 + swz / 64; C = (st & 1) * 32 + (swz % 64) / 2; }
__host__ __device__ __forceinline__ int perm32(int rho) { const int n = rho >> 4, i = rho & 15; return 8 * (i >> 2) + 4 * n + (i & 3); }

struct Unit { int pm, pn, ui; };
struct Gemm { const bf16_t* A; const bf16_t* Bt; int M, N, K; };

struct StaticOrder {
    int nM, nN, nwg, G, c;
    __host__ __device__ void init(int M, int N, int G_, int c_) { nM = M / BM; nN = N / BM; nwg = nM * nN; G = G_; c = c_; }
    __host__ __device__ bool next(int i, Unit& u) const {
        const long L = (long)i * G + c; if (L >= nwg) return false;
        int wgid = (int)L; { const int q = nwg / NXCD, r = nwg % NXCD, xcd = wgid % NXCD, off = wgid / NXCD; wgid = (xcd < r ? xcd * (q + 1) : r * (q + 1) + (xcd - r) * q) + off; }
        const int nig = WGM * nN, gid = wgid / nig, fm = gid * WGM, gsz = (nM - fm) < WGM ? (nM - fm) : WGM;
        u.pm = fm + ((wgid % nig) % gsz); u.pn = (wgid % nig) / gsz; u.ui = i; return true;
    }
    __device__ __forceinline__ void a_ready(const Unit&) const {}
    __device__ __forceinline__ void done(const Unit&) const {}
};

__device__ __forceinline__ unsigned cvt_pk_bf16(float lo, float hi) { unsigned r; asm volatile("v_cvt_pk_bf16_f32 %0, %1, %2" : "=v"(r) : "v"(lo), "v"(hi)); return r; }
typedef float f32x2 __attribute__((ext_vector_type(2)));
template <class Epi, class Sched, bool ALIGN_EPI, bool SP2, int KC, bool ATILED = false>
__device__ __forceinline__ void gemm_phase(PG8_LAS unsigned char* lds, const Gemm g, const Sched& S, const Epi& E) {
    const int tid = threadIdx.x, wid = __builtin_amdgcn_readfirstlane(tid >> 6), lane = tid & 63, wr = wid >> 2, wc = wid & 3, fr = lane & 15, fq = lane >> 4;
    constexpr int K = KC, nt = K / BK;
    unsigned voffA[2], voffB[2];
#pragma unroll
    for (int i = 0; i < 2; ++i) { int R, C; stage_rc(tid * 16 + i * 8192, R, C); const int Rb = Epi::PERM ? ((R & ~31) + perm32(R & 31)) : R;
        voffA[i] = (unsigned)(R * (ATILED ? BK : K) + C) * 2u; voffB[i] = (unsigned)(Rb * K + C) * 2u; }
    const size_t kstep = (size_t)(BK * 2);
    const size_t kstepA = ATILED ? (size_t)(BM * BK * 2) : kstep, hstepA = ATILED ? (size_t)(HALF * BK * 2) : (size_t)HALF * K * 2;
    const size_t hstep = (size_t)HALF * K * 2;
    const size_t tstep = 2 * hstep;
    const unsigned ldsw = (unsigned)wid * 1024u;
    const int aoff = lds_byte(wr * 64 + fr, fq * 8), boff = lds_byte(wc * 32 + fr, fq * 8);
#define PG8_SA(b, h) (((b) * 2 + (h)) * HTB)
#define PG8_SB(b, h) ((4 + (b) * 2 + (h)) * HTB)
#define PG8_STAGE(bufoff, gbase, voff) do { _Pragma("unroll") for (int _i = 0; _i < 2; ++_i) \
        __builtin_amdgcn_global_load_lds((const unsigned*)((const char*)(gbase) + (voff)[_i]), (PG8_LAS unsigned*)(lds + (bufoff) + ldsw + _i * 8192), 16, 0, 0); } while (0)
#define PG8_LDA(dst, b, h) do { _Pragma("unroll") for (int m = 0; m < 4; ++m) _Pragma("unroll") for (int k = 0; k < 2; ++k) dst[m][k] = *(const PG8_LAS bf16x8*)(lds + PG8_SA(b, h) + aoff + m * 2048 + k * 1024); } while (0)
#define PG8_LDB(dst, b, h) do { _Pragma("unroll") for (int n = 0; n < 2; ++n) _Pragma("unroll") for (int k = 0; k < 2; ++k) dst[n][k] = *(const PG8_LAS bf16x8*)(lds + PG8_SB(b, h) + boff + n * 2048 + k * 1024); } while (0)
#define PG8_MMA(ai, bj, At, Bt) do { __builtin_amdgcn_s_setprio(1); _Pragma("unroll") for (int m = 0; m < 4; ++m) _Pragma("unroll") for (int n = 0; n < 2; ++n) _Pragma("unroll") for (int k = 0; k < 2; ++k) \
        acc[ai][bj][m][n] = __builtin_amdgcn_mfma_f32_16x16x32_bf16(Bt[n][k], At[m][k], acc[ai][bj][m][n], 0, 0, 0); __builtin_amdgcn_s_setprio(0); } while (0)
#define PG8_WAIT_V(n) asm volatile("s_waitcnt vmcnt(" #n ")" ::: "memory")
#define PG8_WAIT_L(n) asm volatile("s_waitcnt lgkmcnt(" #n ")" ::: "memory")
#define PG8_BAR __builtin_amdgcn_s_barrier()
#define PG8_SCHED __builtin_amdgcn_sched_barrier(0)
    Unit cur, nxt; int ui = 0;
    if (!S.next(0, cur)) return;
    f32x4 acc[2][2][4][2];
#pragma unroll
    for (int a = 0; a < 2; ++a)
#pragma unroll
        for (int b = 0; b < 2; ++b)
#pragma unroll
            for (int m = 0; m < 4; ++m)
#pragma unroll
                for (int n = 0; n < 2; ++n) acc[a][b][m][n] = (f32x4){0.f, 0.f, 0.f, 0.f};
    bf16x8 At[4][2], B0[2][2], B1[2][2];
    const char* cA = (const char*)g.A + (size_t)cur.pm * tstep; const char* cB = (const char*)g.Bt + (size_t)cur.pn * tstep;
    S.a_ready(cur);
    if constexpr (SP2) {
        PG8_STAGE(PG8_SB(0, 0), cB, voffB); PG8_STAGE(PG8_SB(0, 1), cB + hstep, voffB); PG8_STAGE(PG8_SA(0, 0), cA, voffA); PG8_STAGE(PG8_SA(0, 1), cA + hstepA, voffA);
        if (wr == 1) PG8_BAR;
        PG8_WAIT_V(2); PG8_BAR;
        PG8_STAGE(PG8_SB(1, 0), cB + kstep, voffB); PG8_STAGE(PG8_SA(1, 0), cA + kstepA, voffA); PG8_STAGE(PG8_SB(1, 1), cB + hstep + kstep, voffB);
        PG8_WAIT_V(6); PG8_BAR;
    } else {
        PG8_STAGE(PG8_SB(0, 0), cB, voffB); PG8_STAGE(PG8_SA(0, 0), cA, voffA); PG8_STAGE(PG8_SB(0, 1), cB + hstep, voffB); PG8_STAGE(PG8_SA(0, 1), cA + hstepA, voffA);
        if (wr == 1) PG8_BAR;
        PG8_WAIT_V(4); PG8_BAR;
        PG8_STAGE(PG8_SB(1, 0), cB + kstep, voffB); PG8_STAGE(PG8_SA(1, 0), cA + kstepA, voffA); PG8_STAGE(PG8_SB(1, 1), cB + hstep + kstep, voffB);
        PG8_WAIT_V(6); PG8_BAR;
    }
    for (;;) {
        const bool has_next = S.next(ui + 1, nxt);
        const char* nA = has_next ? (const char*)g.A + (size_t)nxt.pm * tstep : cA; const char* nB = has_next ? (const char*)g.Bt + (size_t)nxt.pn * tstep : cB;
        for (int t = 0; t < nt; t += 2) {
            const bool last = (t == nt - 2);
            const char* a1 = cA + (size_t)(t + 1) * kstepA;
            const char* a2 = last ? nA : cA + (size_t)(t + 2) * kstepA; const char* b2 = last ? nB : cB + (size_t)(t + 2) * kstep;
            const char* a3 = a2 + kstepA; const char* b3 = b2 + kstep;
            if (last && has_next) S.a_ready(nxt);
            if constexpr (SP2) {
            PG8_LDB(B0, 0, 0); PG8_LDB(B1, 0, 1); PG8_SCHED; PG8_LDA(At, 0, 0); PG8_STAGE(PG8_SA(1, 1), a1 + hstepA, voffA);
            PG8_WAIT_V(8); PG8_WAIT_L(0); PG8_BAR; PG8_MMA(0, 0, At, B0); PG8_MMA(0, 1, At, B1); PG8_BAR; PG8_SCHED;
            PG8_LDA(At, 0, 1); PG8_STAGE(PG8_SB(0, 0), b2, voffB); PG8_STAGE(PG8_SB(0, 1), b2 + hstep, voffB); PG8_STAGE(PG8_SA(0, 0), a2, voffA);
            PG8_WAIT_V(8); PG8_WAIT_L(0); PG8_BAR; PG8_MMA(1, 0, At, B0); PG8_MMA(1, 1, At, B1); PG8_BAR; PG8_SCHED;
            PG8_LDB(B0, 1, 0); PG8_LDB(B1, 1, 1); PG8_SCHED; PG8_LDA(At, 1, 0); PG8_STAGE(PG8_SA(0, 1), a2 + hstepA, voffA);
            PG8_WAIT_V(8); PG8_WAIT_L(0); PG8_BAR; PG8_MMA(0, 0, At, B0); PG8_MMA(0, 1, At, B1); PG8_BAR; PG8_SCHED;
            PG8_LDA(At, 1, 1); PG8_STAGE(PG8_SB(1, 0), b3, voffB); PG8_STAGE(PG8_SB(1, 1), b3 + hstep, voffB); PG8_STAGE(PG8_SA(1, 0), a3, voffA);
            PG8_WAIT_V(8); PG8_WAIT_L(0); PG8_BAR; PG8_MMA(1, 0, At, B0); PG8_MMA(1, 1, At, B1); PG8_BAR; PG8_SCHED;
            } else {
            PG8_LDB(B0, 0, 0); PG8_SCHED; PG8_LDA(At, 0, 0); PG8_STAGE(PG8_SA(1, 1), a1 + hstepA, voffA);
            PG8_WAIT_L(8); PG8_BAR; PG8_WAIT_L(0); PG8_MMA(0, 0, At, B0); PG8_BAR; PG8_SCHED;
            PG8_LDB(B1, 0, 1); PG8_STAGE(PG8_SB(0, 0), b2, voffB);
            PG8_BAR; PG8_WAIT_L(0); PG8_MMA(0, 1, At, B1); PG8_BAR;
            PG8_LDA(At, 0, 1); PG8_STAGE(PG8_SA(0, 0), a2, voffA);
            PG8_BAR; PG8_WAIT_L(0); PG8_MMA(1, 0, At, B0); PG8_BAR; PG8_SCHED;
            PG8_STAGE(PG8_SB(0, 1), b2 + hstep, voffB);
            PG8_WAIT_V(6); PG8_BAR; PG8_MMA(1, 1, At, B1); PG8_BAR;
            PG8_LDB(B0, 1, 0); PG8_SCHED; PG8_LDA(At, 1, 0); PG8_STAGE(PG8_SA(0, 1), a2 + hstepA, voffA);
            PG8_WAIT_L(8); PG8_BAR; PG8_WAIT_L(0); PG8_MMA(0, 0, At, B0); PG8_BAR; PG8_SCHED;
            PG8_LDB(B1, 1, 1); PG8_STAGE(PG8_SB(1, 0), b3, voffB);
            PG8_BAR; PG8_WAIT_L(0); PG8_MMA(0, 1, At, B1); PG8_BAR;
            PG8_LDA(At, 1, 1); PG8_STAGE(PG8_SA(1, 0), a3, voffA);
            PG8_BAR; PG8_WAIT_L(0); PG8_MMA(1, 0, At, B0); PG8_BAR; PG8_SCHED;
            PG8_STAGE(PG8_SB(1, 1), b3 + hstep, voffB);
            PG8_WAIT_V(6); PG8_BAR; PG8_MMA(1, 1, At, B1); PG8_BAR;
            }
        }
        if constexpr (ALIGN_EPI) { if (wr == 0) PG8_BAR; }
        if constexpr (!Epi::AFTER_DRAIN) { E(acc, cur, wr, wc, fr, fq); S.done(cur); }
        if (!has_next) break;
#pragma unroll
        for (int a = 0; a < 2; ++a)
#pragma unroll
            for (int b = 0; b < 2; ++b)
#pragma unroll
                for (int m = 0; m < 4; ++m)
#pragma unroll
                    for (int n = 0; n < 2; ++n) acc[a][b][m][n] = (f32x4){0.f, 0.f, 0.f, 0.f};
        cur = nxt; cA = nA; cB = nB; ++ui;
        if constexpr (ALIGN_EPI) { if (wr == 1) PG8_BAR; }
    }
    PG8_WAIT_V(0);
    if constexpr (!ALIGN_EPI) { if (wr == 0) PG8_BAR; }
    PG8_BAR;
    if constexpr (Epi::AFTER_DRAIN) { E.fused(acc, cur, wr, wc, fr, fq, lds, wid, lane); S.done(cur); }
#undef PG8_SA
#undef PG8_SB
#undef PG8_STAGE
#undef PG8_LDA
#undef PG8_LDB
#undef PG8_MMA
#undef PG8_WAIT_V
#undef PG8_WAIT_L
#undef PG8_BAR
#undef PG8_SCHED
}
}

#ifndef MK_N_LAUNCHES
#define MK_N_LAUNCHES 1
#endif
constexpr int NWAVES = 8, NTHR = 512;
constexpr int DM = 1024, NB = 16, SEQ = 2048, NMETA = 16, TT = SEQ + NMETA, DB = 128;
constexpr int MAIN = NB * SEQ;
constexpr int TAIL0 = MAIN, NTAIL = 144;
constexpr int MPAD = 33024;
constexpr int DFF = 2816, NGU = 2 * DFF, NIN = 1280, PW = 512, NH = 8, HD = 64, KVW = 128;
constexpr int PASTLEN = 16384, NPOS = TT + 1;
constexpr float EPS = 1e-6f;
constexpr size_t O_Y = 0, O_YS = 33554432, O_PP = 33685504, O_KP = 33808384, O_VP = 34070528, O_PS = 34332672, O_KS = 35315712, O_VS = 37412864, O_END = 39510016;
constexpr size_t MiB = 1u << 20;
constexpr size_t WS_CTL = 0, WS_ROPE = 1 * MiB, WS_SS = 2 * MiB, WS_SST = 4 * MiB + 65536, WS_W1GU = 5 * MiB, WS_W1D = 16 * MiB, WS_WIN = 22 * MiB, WS_WOUT = 25 * MiB, WS_W2GU = 27 * MiB, WS_W2D = 38 * MiB,
                 WS_XB = 44 * MiB, WS_X = 109 * MiB, WS_ACT = 239 * MiB, WS_U = 239 * MiB, WS_Q = 272 * MiB, WS_K = 305 * MiB, WS_V = 314 * MiB, WS_MIX = 323 * MiB, WS_END = 418 * MiB;
static_assert(WS_SS + (size_t)MAIN * 16 * 4 <= WS_SST && WS_SST + 3 * NTAIL * 32 * 4 <= WS_W1GU && WS_XB + (size_t)MPAD * DM * 2 <= WS_X && WS_X + (size_t)MPAD * DM * 4 <= WS_ACT && WS_ACT + (size_t)MPAD * DFF * 2 <= WS_END, "ws map");
static_assert(WS_U + (size_t)MPAD * PW * 2 <= WS_Q && WS_Q + (size_t)MPAD * PW * 2 <= WS_K && WS_K + (size_t)MPAD * KVW * 2 <= WS_V && WS_V + (size_t)MPAD * KVW * 2 <= WS_MIX && WS_MIX + (size_t)MPAD * DM * 2 <= WS_END, "ws overlay");
constexpr int RING_BYTES = 131072, LDS_BYTES = 147456;

#define LAS __attribute__((address_space(3)))
typedef unsigned short bf16;
typedef unsigned v4u __attribute__((ext_vector_type(4)));
typedef unsigned v2u __attribute__((ext_vector_type(2)));
typedef float f32x4 __attribute__((ext_vector_type(4)));
typedef short bf16x8 __attribute__((ext_vector_type(8)));
typedef short s16x4 __attribute__((ext_vector_type(4)));
#define LDS_WAIT() asm volatile("s_waitcnt lgkmcnt(0)" ::: "memory")
#define RLX_AGENT __ATOMIC_RELAXED, __HIP_MEMORY_SCOPE_AGENT
#define XB_TMO      128
#define XB_XCNT(j)  (256  + 64 * (j))
#define XB_XSUB(j)  (1280 + 64 * (j))
#define XB_XGEN(j)  (2304 + 64 * (j))
#define XB_TOP      3328
#define XB_TOPGEN   3392
#define XCD_BAR_WORDS 3456
#define XB_SPIN_CAP (1u << 18)

__device__ __forceinline__ unsigned xb_ld(unsigned* p)              { return __hip_atomic_load(p, __ATOMIC_RELAXED, __HIP_MEMORY_SCOPE_AGENT); }
__device__ __forceinline__ unsigned xb_add(unsigned* p, unsigned v) { return __hip_atomic_fetch_add(p, v, __ATOMIC_RELAXED, __HIP_MEMORY_SCOPE_AGENT); }
__device__ __forceinline__ unsigned xb_xcc_id() { return (unsigned)__builtin_amdgcn_s_getreg((3 << 11) | 20) & 0xFu; }
#define XB_SPIN(cond, bar) do { unsigned _sp = 0; while (cond) { __builtin_amdgcn_s_sleep(1); \
    if ((++_sp & 255u) == 0u) { if (xb_ld(&(bar)[XB_TMO])) break; if (_sp > XB_SPIN_CAP) { atomicAdd(&(bar)[XB_TMO], 1u); break; } } } } while (0)

struct XcdBarrier {
    unsigned* bar; unsigned x;
    volatile LAS unsigned* st;
};

__device__ __forceinline__ XcdBarrier xcd_barrier_post(unsigned* bar, volatile LAS unsigned* st) {
    XcdBarrier b; b.bar = bar; b.x = xb_xcc_id(); b.st = st;
    if (threadIdx.x == 0) (void)xb_add(&bar[XB_XCNT(b.x)], 1u);
    return b;
}
__device__ __forceinline__ void xcd_barrier_complete(unsigned* bar, unsigned x, unsigned& nloc, unsigned& nx) {
    const unsigned G = gridDim.x * gridDim.y * gridDim.z;
    unsigned sum, cnt, mine, sp = 0u;
    for (;;) {
        sum = 0u; cnt = 0u; mine = 0u;
#pragma unroll
        for (unsigned j = 0; j < 16; ++j) { const unsigned c = xb_ld(&bar[XB_XCNT(j)]); sum += c; cnt += (c > 0u) ? 1u : 0u; mine = (j == x) ? c : mine; }
        if (sum == G) break;
        __builtin_amdgcn_s_sleep(1);
        if ((++sp & 255u) == 0u) { if (xb_ld(&bar[XB_TMO])) break; if (sp > XB_SPIN_CAP) { atomicAdd(&bar[XB_TMO], 1u); break; } }
    }
    nloc = mine > 0u ? mine : 1u; nx = cnt > 0u ? cnt : 1u;
}

__device__ __forceinline__ void xcd_barrier(const XcdBarrier& b) {
    asm volatile("s_waitcnt vmcnt(0)" ::: "memory");
    __syncthreads();
    if (threadIdx.x == 0) {
        unsigned* bar = b.bar;
        __builtin_amdgcn_s_waitcnt(0);
        unsigned nloc = b.st[0], nx = b.st[1];
        if (nloc == 0u) { xcd_barrier_complete(bar, b.x, nloc, nx); b.st[0] = nloc; b.st[1] = nx; }
        const unsigned old = xb_add(&bar[XB_XSUB(b.x)], 1u);
        const unsigned gen = old / nloc;
        if (old + 1u == (gen + 1u) * nloc) {
            __builtin_amdgcn_fence(__ATOMIC_RELEASE, "agent");
            asm volatile("s_waitcnt vmcnt(0)" ::: "memory");
            const unsigned og = xb_add(&bar[XB_TOP], 1u);
            const unsigned tg = og / nx;
            if (og + 1u == (tg + 1u) * nx) xb_add(&bar[XB_TOPGEN], 1u);
            else XB_SPIN(xb_ld(&bar[XB_TOPGEN]) == tg, bar);
            __builtin_amdgcn_fence(__ATOMIC_ACQUIRE, "agent");
            xb_add(&bar[XB_XGEN(b.x)], 1u);
            asm volatile("s_waitcnt vmcnt(0)" ::: "memory");
        } else {
            XB_SPIN(xb_ld(&bar[XB_XGEN(b.x)]) == gen, bar);
            __builtin_amdgcn_fence(__ATOMIC_ACQUIRE, "agent");
            asm volatile("s_waitcnt vmcnt(0)" ::: "memory");
        }
    }
    __syncthreads();
}


using pg8::cvt_pk_bf16;
typedef short v4i16_t __attribute__((ext_vector_type(4)));
__device__ __forceinline__ s16x4 vtr(const LAS unsigned char* p) { return __builtin_bit_cast(s16x4, __builtin_amdgcn_ds_read_tr16_b64_v4i16((LAS v4i16_t*)p)); }
__device__ __forceinline__ float bf2f(unsigned short h) { return __uint_as_float((unsigned)h << 16); }
__device__ __forceinline__ float row_rstd(const float* SS, int r) {
    const f32x4* p = (const f32x4*)(SS + (size_t)r * 16);
    const f32x4 a = p[0], b = p[1], c = p[2], d = p[3]; const f32x4 s = (a + b) + (c + d);
    return __builtin_amdgcn_rsqf(((s.x + s.y) + (s.z + s.w)) * (1.0f / DM) + EPS);
}
__device__ __forceinline__ float silu_mul(float g, float u) { return g * __builtin_amdgcn_rcpf(1.0f + __builtin_amdgcn_exp2f(-1.4426950408889634f * g)) * u; }

struct Args {
    const float* in[22]; float* out; unsigned char* ws; float invf[8]; int ph_lo, ph_hi;
};
typedef const __attribute__((address_space(4))) Args* KArgs;
__device__ __forceinline__ KArgs kargs_now() { KArgs ka = (KArgs)__builtin_amdgcn_kernarg_segment_ptr(); asm volatile("" : "+s"(ka)); return ka; }
struct EpiSwiGLU {
    static constexpr bool PERM = true, AFTER_DRAIN = false;
    const LAS float* rst;
    __device__ __forceinline__ void operator()(const f32x4 (&acc)[2][2][4][2], const pg8::Unit& u, int wr, int wc, int fr, int fq) const {
        const KArgs ka = kargs_now(); unsigned char* ws = ka->ws; bf16* O = (bf16*)(ws + WS_ACT); const LAS float* rt = rst + u.ui * 256 + wr * 64 + fr;
        const int row0 = u.pm * 256 + wr * 64 + fr, col0 = u.pn * 128 + wc * 32 + 8 * fq;
#pragma unroll
        for (int ai = 0; ai < 2; ++ai)
#pragma unroll
            for (int m = 0; m < 4; ++m) {
                const int r = row0 + ai * 128 + m * 16; const float rs = rt[ai * 128 + m * 16];
                const f32x4 g0 = acc[ai][0][m][0] * rs, g1 = acc[ai][0][m][1] * rs, u0 = acc[ai][1][m][0] * rs, u1 = acc[ai][1][m][1] * rs;
                v4u w; w.x = cvt_pk_bf16(silu_mul(g0[0], u0[0]), silu_mul(g0[1], u0[1])); w.y = cvt_pk_bf16(silu_mul(g0[2], u0[2]), silu_mul(g0[3], u0[3]));
                w.z = cvt_pk_bf16(silu_mul(g1[0], u1[0]), silu_mul(g1[1], u1[1])); w.w = cvt_pk_bf16(silu_mul(g1[2], u1[2]), silu_mul(g1[3], u1[3]));
                __builtin_nontemporal_store(w, (v4u*)(O + (size_t)(r >> 8) * (256 * DFF) + (size_t)(col0 >> 6) * (256 * 64) + (r & 255) * 64 + (col0 & 63)));
            }
    }
};
template <int MODE> struct EpiRes {
    static constexpr bool PERM = true, AFTER_DRAIN = false;
    __device__ __forceinline__ void operator()(const f32x4 (&acc)[2][2][4][2], const pg8::Unit& u, int wr, int wc, int fr, int fq) const {
        const KArgs ka = kargs_now(); unsigned char* ws = ka->ws; bf16* XB = (bf16*)(ws + WS_XB); float* SS = (float*)(ws + WS_SS); float* out = ka->out;
        constexpr float alpha = (MODE == 1) ? 1.0f : 0.5f;
        const int col0 = u.pn * 256 + wc * 32 + 8 * fq;
        v4u xin[2][4][2];
#pragma unroll
        for (int ai = 0; ai < 2; ++ai)
#pragma unroll
            for (int m = 0; m < 4; ++m) { const bf16* xrow = XB + (size_t)(u.pm * 256 + ai * 128 + wr * 64 + m * 16 + fr) * DM + col0;
#pragma unroll
                for (int bj = 0; bj < 2; ++bj) xin[ai][m][bj] = *(const v4u*)(xrow + bj * 128); }
#pragma unroll
        for (int ai = 0; ai < 2; ++ai)
#pragma unroll
            for (int m = 0; m < 4; ++m) {
                const int r = u.pm * 256 + ai * 128 + wr * 64 + m * 16 + fr;
                bf16* xrow = XB + (size_t)r * DM + col0; float* dst = out + O_Y + (size_t)r * DM + col0;
                float ss = 0.f;
#pragma unroll
                for (int bj = 0; bj < 2; ++bj) {
                    const v4u xi = xin[ai][m][bj]; f32x4 v0 = acc[ai][bj][m][0] * alpha, v1 = acc[ai][bj][m][1] * alpha;
                    v0[0] += __uint_as_float(xi.x << 16); v0[1] += __uint_as_float(xi.x & 0xffff0000u); v0[2] += __uint_as_float(xi.y << 16); v0[3] += __uint_as_float(xi.y & 0xffff0000u);
                    v1[0] += __uint_as_float(xi.z << 16); v1[1] += __uint_as_float(xi.z & 0xffff0000u); v1[2] += __uint_as_float(xi.w << 16); v1[3] += __uint_as_float(xi.w & 0xffff0000u);
                    if (MODE < 2) { v4u w; w.x = cvt_pk_bf16(v0[0], v0[1]); w.y = cvt_pk_bf16(v0[2], v0[3]); w.z = cvt_pk_bf16(v1[0], v1[1]); w.w = cvt_pk_bf16(v1[2], v1[3]); *(v4u*)(xrow + bj * 128) = w;
                        ss += ((v0[0] * v0[0] + v0[1] * v0[1]) + (v0[2] * v0[2] + v0[3] * v0[3])) + ((v1[0] * v1[0] + v1[1] * v1[1]) + (v1[2] * v1[2] + v1[3] * v1[3])); }
                    else { __builtin_nontemporal_store(v0, (f32x4*)(dst + bj * 128)); __builtin_nontemporal_store(v1, (f32x4*)(dst + bj * 128 + 4)); }
                }
                if (MODE < 2) { ss += __shfl_xor(ss, 16); ss += __shfl_xor(ss, 32); if (fq == 0) SS[(size_t)r * 16 + u.pn * 4 + wc] = ss; }
            }
    }
};
struct EpiIn {
    static constexpr bool PERM = true, AFTER_DRAIN = false;
    const LAS float* rst;
    __device__ __forceinline__ void operator()(const f32x4 (&acc)[2][2][4][2], const pg8::Unit& u, int wr, int wc, int fr, int fq) const {
        const KArgs ka = kargs_now(); unsigned char* ws = ka->ws; const LAS float* rt = rst + u.ui * 256 + wr * 64 + fr; bf16 *U = (bf16*)(ws + WS_U), *Q = (bf16*)(ws + WS_Q), *Kb = (bf16*)(ws + WS_K), *Vb = (bf16*)(ws + WS_V);
        const float* rope = (const float*)(ws + WS_ROPE); const float* qn = ka->in[12]; const float* kn = ka->in[13]; float* out = ka->out;
        const int row0 = u.pm * 256 + wr * 64 + fr;
        if (u.pn < 2) {
            const int col0 = u.pn * 256 + wc * 32 + 8 * fq;
#pragma unroll
            for (int ai = 0; ai < 2; ++ai)
#pragma unroll
                for (int m = 0; m < 4; ++m) {
                    const int r = row0 + ai * 128 + m * 16; const float rs = rt[ai * 128 + m * 16];
                    float* po = nullptr;
                    { const int b = r >> 11, t = (r & (SEQ - 1)) + NMETA; if (t >= TT - 15) po = out + O_PP + ((size_t)b * 15 + (t - (TT - 15))) * PW; }
#pragma unroll
                    for (int bj = 0; bj < 2; ++bj) {
                        const int c = col0 + bj * 128; const f32x4 v0 = acc[ai][bj][m][0] * rs, v1 = acc[ai][bj][m][1] * rs;
                        v4u w; w.x = cvt_pk_bf16(v0[0], v0[1]); w.y = cvt_pk_bf16(v0[2], v0[3]); w.z = cvt_pk_bf16(v1[0], v1[1]); w.w = cvt_pk_bf16(v1[2], v1[3]);
                        *(v4u*)(U + (size_t)r * PW + c) = w;
                        if (po) { *(f32x4*)(po + c) = v0; *(f32x4*)(po + c + 4) = v1; }
                    }
                }
        } else {
            int kind, hcol, ld; bf16* dst; const float* gain; size_t oprompt;
            if (u.pn < 4) { kind = 0; hcol = 64 * (4 * (u.pn - 2) + wc); ld = PW; dst = Q; gain = qn; oprompt = 0; }
            else if (wc < 2) { kind = 1; hcol = 64 * wc; ld = KVW; dst = Kb; gain = kn; oprompt = O_KP; }
            else { kind = 2; hcol = 64 * (wc - 2); ld = KVW; dst = Vb; gain = kn; oprompt = O_VP; }
            const int d0[2] = {fq == 0 ? 0 : 16 + 8 * (fq - 1), fq == 0 ? 8 : 40 + 8 * (fq - 1)};
            f32x4 gv[2][2];
#pragma unroll
            for (int bj = 0; bj < 2; ++bj)
#pragma unroll
                for (int n = 0; n < 2; ++n) gv[bj][n] = *(const f32x4*)(gain + d0[bj] + 4 * n);
            const bool rot = (kind < 2) && (fq == 0);
            f32x4 rcs[8][2], rsn[8][2];
            if (rot) { const float* rp = rope + (size_t)((row0 & (SEQ - 1)) + NMETA) * 16;
#pragma unroll
                for (int n = 0; n < 2; ++n) { rcs[0][n] = *(const f32x4*)(rp + 4 * n); rsn[0][n] = *(const f32x4*)(rp + 8 + 4 * n); } }
#pragma unroll
            for (int ai = 0; ai < 2; ++ai) {
#pragma unroll
                for (int m = 0; m < 4; ++m) {
                    if (rot && (ai * 4 + m) < 7) { const int r1 = row0 + ((ai * 4 + m + 1) >> 2) * 128 + ((ai * 4 + m + 1) & 3) * 16; const float* rp = rope + (size_t)((r1 & (SEQ - 1)) + NMETA) * 16;
#pragma unroll
                        for (int n = 0; n < 2; ++n) { rcs[ai * 4 + m + 1][n] = *(const f32x4*)(rp + 4 * n); rsn[ai * 4 + m + 1][n] = *(const f32x4*)(rp + 8 + 4 * n); } }
                    const int r = row0 + ai * 128 + m * 16; const float rs = rt[ai * 128 + m * 16];
                    f32x4 z[2][2];
#pragma unroll
                    for (int bj = 0; bj < 2; ++bj)
#pragma unroll
                        for (int n = 0; n < 2; ++n) z[bj][n] = acc[ai][bj][m][n] * rs;
                    const int b = r >> 11, t = (r & (SEQ - 1)) + NMETA;
                    if (kind < 2) {
                        float ss = 0.f;
#pragma unroll
                        for (int bj = 0; bj < 2; ++bj)
#pragma unroll
                            for (int n = 0; n < 2; ++n) ss += (z[bj][n][0] * z[bj][n][0] + z[bj][n][1] * z[bj][n][1]) + (z[bj][n][2] * z[bj][n][2] + z[bj][n][3] * z[bj][n][3]);
                        ss += __shfl_xor(ss, 16); ss += __shfl_xor(ss, 32);
                        const float inv = __builtin_amdgcn_rsqf(ss * (1.0f / HD) + EPS);
#pragma unroll
                        for (int bj = 0; bj < 2; ++bj)
#pragma unroll
                            for (int n = 0; n < 2; ++n) z[bj][n] = z[bj][n] * inv * gv[bj][n];
                        if (fq == 0) {
#pragma unroll
                            for (int n = 0; n < 2; ++n) { const f32x4 cs = rcs[ai * 4 + m][n], sn = rsn[ai * 4 + m][n]; const f32x4 x1 = z[0][n], x2 = z[1][n]; z[0][n] = x1 * cs - x2 * sn; z[1][n] = x2 * cs + x1 * sn; }
                        }
                    }
                    float* po = nullptr;
                    if (kind > 0 && t >= TT - 128) po = out + oprompt + ((size_t)b * 128 + (t - (TT - 128))) * KVW + hcol;
#pragma unroll
                    for (int bj = 0; bj < 2; ++bj) {
                        v4u w; w.x = cvt_pk_bf16(z[bj][0][0], z[bj][0][1]); w.y = cvt_pk_bf16(z[bj][0][2], z[bj][0][3]); w.z = cvt_pk_bf16(z[bj][1][0], z[bj][1][1]); w.w = cvt_pk_bf16(z[bj][1][2], z[bj][1][3]);
                        *(v4u*)(dst + (size_t)r * ld + hcol + d0[bj]) = w;
                        if (po) { *(f32x4*)(po + d0[bj]) = z[bj][0]; *(f32x4*)(po + d0[bj] + 4) = z[bj][1]; }
                    }
                }
            }
        }
    }
};

__device__ __forceinline__ float wave_sum(float v) {
#pragma unroll
    for (int o = 1; o < 64; o <<= 1) v += __shfl_xor(v, o);
    return v;
}
template <bool HG>
__device__ __forceinline__ void transpose_item(const float* W, int N, const float* gain, bf16* WT, int ldt, int nrow0, int k0, int sc, LAS float* scr, int lane) {
#pragma unroll
    for (int i = 0; i < 32; ++i) { const int kk = 2 * i + (lane >> 5); float v = __builtin_nontemporal_load(W + (size_t)(k0 + kk) * N + sc); if (HG) v *= gain[k0 + kk]; scr[kk * 33 + (lane & 31)] = v; }
    LDS_WAIT(); asm volatile("" ::: "memory");
    const int c = lane & 7;
#pragma unroll
    for (int j = 0; j < 4; ++j) { const int n = (lane >> 3) + 8 * j; const LAS float* s = scr + (8 * c) * 33 + n;
        v4u o; o.x = cvt_pk_bf16(s[0 * 33], s[1 * 33]); o.y = cvt_pk_bf16(s[2 * 33], s[3 * 33]); o.z = cvt_pk_bf16(s[4 * 33], s[5 * 33]); o.w = cvt_pk_bf16(s[6 * 33], s[7 * 33]);
        *(v4u*)(WT + (size_t)(nrow0 + n) * ldt + k0 + 8 * c) = o; }
    LDS_WAIT(); asm volatile("" ::: "memory");
}
__device__ __forceinline__ int win_src(int np) {
    const int pn = np >> 8; if (pn < 2) return np;
    const int bj = (np >> 7) & 1, wc = (np >> 5) & 3, j = np & 31, dm = (j < 8) ? 8 * bj + j : 16 + 24 * bj + (j - 8);
    if (pn < 4) return 512 + 64 * (4 * (pn - 2) + wc) + dm;
    return (wc < 2) ? 1024 + 64 * wc + dm : 1152 + 64 * (wc - 2) + dm;
}
__device__ __forceinline__ int win_row(int pn, int wc, int d) {
    const int bj = (d < 8) ? 0 : (d < 16) ? 1 : (d < 40) ? 0 : 1, j = (d < 8) ? d : (d < 16) ? d - 8 : (d < 40) ? d - 8 : d - 32;
    return 256 * pn + 128 * bj + 32 * wc + j;
}

constexpr int SLAB_P = 33, SLAB_F = NTAIL * SLAB_P, SLAB_B = SLAB_F * 4;
constexpr int T_SLABS = 0, T_R0 = 4 * SLAB_B, T_R1 = 5 * SLAB_B, T_RS = 6 * SLAB_B;
static_assert(T_RS + NTAIL * 4 <= RING_BYTES, "tail LDS");
template <int K, int MT = 9>
__device__ __forceinline__ void skinny_pass(const bf16* A, const bf16* bp0, const bf16* bp1, LAS unsigned char* lds, int roff, int tid, int wave, int lane, int m0 = 0) {
    constexpr int KW = K / 8, NS = KW / 32;
    const int c = lane & 15, g = lane >> 4;
    const bf16* ap = A + (size_t)(16 * m0 + c) * K + wave * KW + 8 * g;     const bf16* b0 = bp0 + wave * KW + 8 * g; const bf16* b1 = bp1 + wave * KW + 8 * g;
    f32x4 acc[MT][2];
#pragma unroll
    for (int m = 0; m < MT; ++m) { acc[m][0] = (f32x4){0.f, 0.f, 0.f, 0.f}; acc[m][1] = (f32x4){0.f, 0.f, 0.f, 0.f}; }
    bf16x8 af[MT], bf0, bf1;
#pragma unroll
    for (int m = 0; m < MT; ++m) af[m] = *(const bf16x8*)(ap + (size_t)(16 * m) * K);
    bf0 = *(const bf16x8*)(b0); bf1 = *(const bf16x8*)(b1);
#pragma unroll (MT <= 3 ? 4 : 1)
    for (int ks = 0; ks < NS; ++ks) {
        const int kn = (ks + 1 < NS) ? ks + 1 : ks;
        bf16x8 an[MT];
#pragma unroll
        for (int m = 0; m < MT; ++m) an[m] = *(const bf16x8*)(ap + (size_t)(16 * m) * K + 32 * kn);
        const bf16x8 bn0 = *(const bf16x8*)(b0 + 32 * kn), bn1 = *(const bf16x8*)(b1 + 32 * kn);
#pragma unroll
        for (int m = 0; m < MT; ++m) { acc[m][0] = __builtin_amdgcn_mfma_f32_16x16x32_bf16(af[m], bf0, acc[m][0], 0, 0, 0); acc[m][1] = __builtin_amdgcn_mfma_f32_16x16x32_bf16(af[m], bf1, acc[m][1], 0, 0, 0); }
#pragma unroll
        for (int m = 0; m < MT; ++m) af[m] = an[m];
        bf0 = bn0; bf1 = bn1;
    }
    LAS float* sl = (LAS float*)(lds + T_SLABS) + (wave & 3) * SLAB_F + (4 * g) * SLAB_P + c;
    if (wave >= 4) {
#pragma unroll
        for (int m = 0; m < MT; ++m)
#pragma unroll
            for (int n = 0; n < 2; ++n)
#pragma unroll
                for (int e = 0; e < 4; ++e) sl[(16 * m + e) * SLAB_P + 16 * n] = acc[m][n][e];
    }
    __syncthreads();
    if (wave < 4) {
#pragma unroll
        for (int m = 0; m < MT; ++m)
#pragma unroll
            for (int n = 0; n < 2; ++n)
#pragma unroll
                for (int e = 0; e < 4; ++e) { const float v = acc[m][n][e] + sl[(16 * m + e) * SLAB_P + 16 * n]; sl[(16 * m + e) * SLAB_P + 16 * n] = v; }
    }
    __syncthreads();
    { const LAS float* s0 = (const LAS float*)(lds + T_SLABS); LAS float* R = (LAS float*)(lds + roff);
      for (int idx = tid; idx < 16 * MT * 32; idx += NTHR) { const int o = (idx >> 5) * SLAB_P + (idx & 31); R[o] = (s0[o] + s0[SLAB_F + o]) + (s0[2 * SLAB_F + o] + s0[3 * SLAB_F + o]); } }
    __syncthreads();
}
__device__ __forceinline__ void tail_rstd(const float* sst, LAS unsigned char* lds, int tid) {
    if (tid < NTAIL) { const f32x4* p = (const f32x4*)(sst + (size_t)tid * 32); f32x4 s = p[0];
#pragma unroll
        for (int i = 1; i < 8; ++i) s += p[i];
        ((LAS float*)(lds + T_RS))[tid] = __builtin_amdgcn_rsqf(((s.x + s.y) + (s.z + s.w)) * (1.0f / DM) + EPS); }
    __syncthreads();
}

constexpr int I_G = 16 * 88, I_IN = 16 * 40, I_OA = 8 * 32, I_OP = 1024, NITEMS = 6 * I_G + I_IN + I_OA + I_OP;
__device__ __forceinline__ void conv_item(int r, KArgs ka, LAS float* scr, int lane) {
    unsigned char* ws = ka->ws;
    bf16 *W1GU = (bf16*)(ws + WS_W1GU), *W1D = (bf16*)(ws + WS_W1D), *WIN = (bf16*)(ws + WS_WIN), *WOUT = (bf16*)(ws + WS_WOUT), *W2GU = (bf16*)(ws + WS_W2GU), *W2D = (bf16*)(ws + WS_W2D);
    if (r < 6 * I_G) {
        const int f = r / (3 * I_G); r -= f * 3 * I_G; const int which = r / I_G; r -= which * I_G;
        const float* gain = ka->in[f ? 18 : 6];
        if (which < 2) { const int kb = r / 88, nb = r % 88, n0 = 32 * nb; const float* W = ka->in[(f ? 19 : 7) + which];
            transpose_item<true>(W, DFF, gain, f ? W2GU : W1GU, DM, 256 * (n0 >> 7) + (n0 & 127) + 128 * which, 64 * kb, n0 + (lane & 31), scr, lane); }
        else { const int kb = r / 32, nb = r % 32; const float* W = ka->in[f ? 21 : 9];
            transpose_item<false>(W, DM, nullptr, f ? W2D : W1D, DFF, 32 * nb, 64 * kb, 32 * nb + (lane & 31), scr, lane); }
        return;
    }
    r -= 6 * I_G;
    if (r < I_IN) { const int kb = r / 40, nb = r % 40; transpose_item<true>(ka->in[11], NIN, ka->in[10], WIN, DM, 32 * nb, 64 * kb, win_src(32 * nb + (lane & 31)), scr, lane); return; }
    r -= I_IN;
    if (r < I_OA) { const int kb = r / 32, nb = r % 32; transpose_item<false>(ka->in[17] + (size_t)PW * DM, DM, nullptr, WOUT + PW, DM, 32 * nb, 64 * kb, 32 * nb + (lane & 31), scr, lane); return; }
    r -= I_OA;
    {
        const int g = r >> 8, ib = (r >> 4) & 15, nb = r & 15, n = 64 * nb + lane;
        const float* pw = ka->in[15] + ((size_t)g * 128 + 8 * ib) * 128; const float* psc = ka->in[16] + 128 * g; const float* wo = ka->in[17] + (size_t)(128 * g) * DM + n;
        float a[8];
#pragma unroll
        for (int ii = 0; ii < 8; ++ii) a[ii] = 0.f;
#pragma unroll 32
        for (int j = 0; j < 128; ++j) { const float wv = wo[(size_t)j * DM] * psc[j];
#pragma unroll
            for (int ii = 0; ii < 8; ++ii) a[ii] += pw[ii * 128 + j] * wv; }
        v4u o; o.x = cvt_pk_bf16(a[0], a[1]); o.y = cvt_pk_bf16(a[2], a[3]); o.z = cvt_pk_bf16(a[4], a[5]); o.w = cvt_pk_bf16(a[6], a[7]);
        *(v4u*)(WOUT + (size_t)n * DM + 128 * g + 8 * ib) = o;
    }
}

__global__ void __launch_bounds__(NTHR, 2) hymba_fwd(Args args) {
    extern __shared__ __attribute__((aligned(16))) unsigned char lds_raw[];
    LAS unsigned char* lds = (LAS unsigned char*)lds_raw;
    const int tid = threadIdx.x, lane = tid & 63, wave = __builtin_amdgcn_readfirstlane(tid >> 6);
    const int G = gridDim.x, bx = blockIdx.x, vcu = (G % 8 == 0) ? (bx % 8) * (G / 8) + bx / 8 : bx;
    unsigned char* ws = args.ws;
    const float *x_prompt = args.in[0], *x_sample = args.in[1], *state_pool = args.in[2], *cache_k = args.in[3], *cache_v = args.in[4], *meta = args.in[5];
    float* out = args.out;
    float* SS = (float*)(ws + WS_SS); float* SST = (float*)(ws + WS_SST); float* ROPE = (float*)(ws + WS_ROPE);
    bf16 *W1GU = (bf16*)(ws + WS_W1GU), *W1D = (bf16*)(ws + WS_W1D), *WIN = (bf16*)(ws + WS_WIN), *WOUT = (bf16*)(ws + WS_WOUT), *W2GU = (bf16*)(ws + WS_W2GU), *W2D = (bf16*)(ws + WS_W2D);
    bf16 *XB = (bf16*)(ws + WS_XB), *ACT = (bf16*)(ws + WS_ACT), *Ub = (bf16*)(ws + WS_U), *Qb = (bf16*)(ws + WS_Q), *Kb = (bf16*)(ws + WS_K), *Vb = (bf16*)(ws + WS_V), *MIX = (bf16*)(ws + WS_MIX);
    const int lo = args.ph_lo, hi = args.ph_hi;
#define IN(k) (lo <= (k) && (k) < hi)
#define SEAM(k) do { if (IN(k) && IN((k) + 1)) { xcd_barrier(xbar); } } while (0)
    volatile LAS unsigned* xst = (volatile LAS unsigned*)(lds + RING_BYTES + 256);
    if (tid == 0) { xst[0] = 0u; xst[1] = 0u; }
    __syncthreads();
    XcdBarrier xbar; xbar.bar = (unsigned*)(ws + WS_CTL) + 4096; xbar.x = 0; xbar.st = nullptr;
    if (hi - lo > 1) xbar = xcd_barrier_post((unsigned*)(ws + WS_CTL) + 4096, xst);
    if (hi > 64) cg::this_grid().sync();

    LAS float* RST = (LAS float*)(lds + RING_BYTES + 1024);
#define BUILD_RST(S_) do { const int nU_ = ((S_).nwg - (S_).c + (S_).G - 1) / (S_).G, ntab_ = nU_ * 256; \
        for (int base_ = 0; base_ < ntab_; base_ += 4 * NTHR) { f32x4 p_[4][4]; \
            _Pragma("unroll") for (int e_ = 0; e_ < 4; ++e_) { int idx_ = base_ + tid + NTHR * e_; idx_ = idx_ < ntab_ ? idx_ : ntab_ - 1; pg8::Unit uu_; (S_).next(idx_ >> 8, uu_); \
                const f32x4* q_ = (const f32x4*)(SS + ((size_t)uu_.pm * 256 + (idx_ & 255)) * 16); p_[e_][0] = q_[0]; p_[e_][1] = q_[1]; p_[e_][2] = q_[2]; p_[e_][3] = q_[3]; } \
            _Pragma("unroll") for (int e_ = 0; e_ < 4; ++e_) { const int idx_ = base_ + tid + NTHR * e_; const f32x4 s_ = (p_[e_][0] + p_[e_][1]) + (p_[e_][2] + p_[e_][3]); \
                if (idx_ < ntab_) RST[idx_] = __builtin_amdgcn_rsqf(((s_.x + s_.y) + (s_.z + s_.w)) * (1.0f / DM) + EPS); } } \
        __syncthreads(); } while (0)
#define TAIL_SWIGLU(WGU, sst) do { tail_rstd((sst), lds, tid); \
        for (int su = bx; su < DFF / 16; su += G) { const int n0 = 16 * su, gr = 256 * (n0 >> 7) + (n0 & 127) + (lane & 15); \
            skinny_pass<DM>(XB + (size_t)TAIL0 * DM, (WGU) + (size_t)gr * DM, (WGU) + (size_t)(gr + 128) * DM, lds, T_R0, tid, wave, lane); \
            const LAS float* R = (const LAS float*)(lds + T_R0); const LAS float* RS = (const LAS float*)(lds + T_RS); \
            for (int idx = tid; idx < NTAIL * 16; idx += NTHR) { const int row = idx >> 4, col = idx & 15; const float rs = RS[row]; \
                ACT[(size_t)(TAIL0 + row) * DFF + n0 + col] = (bf16)(cvt_pk_bf16(silu_mul(R[row * SLAB_P + col] * rs, R[row * SLAB_P + 16 + col] * rs), 0.f) & 0xffffu); } \
            __syncthreads(); } } while (0)
#define TAIL_RES(MODE, KK, Aten, WT, sst_out) do { \
        for (int su = bx; su < 3 * (DM / 32); su += G) { const int cb = su / 3, mg = su - 3 * cb, n0 = 32 * cb, m0 = 3 * mg;     \
            skinny_pass<KK, 3>((Aten) + (size_t)TAIL0 * (KK), (WT) + (size_t)(n0 + (lane & 15)) * (KK), (WT) + (size_t)(n0 + 16 + (lane & 15)) * (KK), lds, T_R0, tid, wave, lane, m0); \
            const LAS float* R = (const LAS float*)(lds + T_R0); \
            for (int idx = tid; idx < 48 * 32; idx += NTHR) { const int rrel = idx >> 5, row = 16 * m0 + rrel, col = idx & 31; const size_t xo = (size_t)(TAIL0 + row) * DM + n0 + col; \
                const float v = bf2f(XB[xo]) + (((MODE) == 1) ? 1.0f : 0.5f) * R[rrel * SLAB_P + col]; \
                if ((MODE) < 2) { XB[xo] = (bf16)(cvt_pk_bf16(v, 0.f) & 0xffffu); float ss = v * v; ss += __shfl_xor(ss, 1); ss += __shfl_xor(ss, 2); ss += __shfl_xor(ss, 4); ss += __shfl_xor(ss, 8); ss += __shfl_xor(ss, 16); \
                    if (col == 0) (sst_out)[(size_t)row * 32 + cb] = ss; } \
                else if (row >= NMETA) out[O_YS + (size_t)(row - NMETA) * DM + n0 + col] = v; } \
            __syncthreads(); } } while (0)

    if (IN(0)) {
        LAS float* scr = (LAS float*)(lds + wave * 16384);
        const int gw = vcu * NWAVES + wave, NGW = G * NWAVES;
        { const KArgs ka = (KArgs)__builtin_amdgcn_kernarg_segment_ptr();
          for (int it = gw; it < 3 * I_G + I_IN; it += NGW) conv_item(it < 3 * I_G ? it : it + 3 * I_G, ka, scr, lane); }
        for (int r4 = gw; r4 < (MAIN + NTAIL) / 4; r4 += NGW) {
            f32x4 v[4][4];
#pragma unroll
            for (int rr = 0; rr < 4; ++rr) { const int r = 4 * r4 + rr; const float* src = (r < MAIN) ? x_prompt + (size_t)r * DM : (r < MAIN + NMETA) ? meta + (size_t)(r - MAIN) * DM : x_sample + (size_t)(r - MAIN - NMETA) * DM;
#pragma unroll
                for (int j = 0; j < 4; ++j) v[rr][j] = __builtin_nontemporal_load((const f32x4*)src + lane + 64 * j); }
#pragma unroll
            for (int rr = 0; rr < 4; ++rr) { const int r = 4 * r4 + rr; float s = 0.f;
#pragma unroll
                for (int j = 0; j < 4; ++j) s += (v[rr][j].x * v[rr][j].x + v[rr][j].y * v[rr][j].y) + (v[rr][j].z * v[rr][j].z + v[rr][j].w * v[rr][j].w);
                s = wave_sum(s);
#pragma unroll
                for (int j = 0; j < 4; ++j) { v2u w; w.x = cvt_pk_bf16(v[rr][j].x, v[rr][j].y); w.y = cvt_pk_bf16(v[rr][j].z, v[rr][j].w); ((v2u*)(XB + (size_t)r * DM))[lane + 64 * j] = w; }
                if (r < MAIN) { if (lane < 16) SS[(size_t)r * 16 + lane] = (lane == 0) ? s : 0.f; } else if (lane < 32) SST[(size_t)(r - MAIN) * 32 + lane] = (lane == 0) ? s : 0.f; }
        }
        const int gt = vcu * NTHR + tid, NGT = G * NTHR;
        for (int i = gt; i < NPOS * 8; i += NGT) {
            const int p = i >> 3, f = i & 7; const float pos = (p < TT) ? (float)p : (float)PASTLEN; const float ang = pos * args.invf[f];
            const double xd = (double)ang, nn = __builtin_rint(xd * 0.15915494309189535), rr = __builtin_fma(-nn, 6.283185307179586, xd), r2 = rr * rr;
            double c = 1.0, s = rr, tc = 1.0, ts = rr;
#pragma unroll
            for (int k = 1; k <= 15; ++k) { tc *= -r2 * (1.0 / (double)((2 * k - 1) * (2 * k))); c += tc; ts *= -r2 * (1.0 / (double)((2 * k) * (2 * k + 1))); s += ts; }
            ROPE[(size_t)p * 16 + f] = (float)c; ROPE[(size_t)p * 16 + 8 + f] = (float)s;
        }
    }
    SEAM(0);
    if (IN(1)) { TAIL_SWIGLU(W1GU, SST);
        { pg8::Gemm g{XB, W1GU, MAIN, NGU, DM}; pg8::StaticOrder S; S.init(MAIN, NGU, G, bx); BUILD_RST(S); EpiSwiGLU E{RST};
        pg8::gemm_phase<EpiSwiGLU, pg8::StaticOrder, true, true, DM>(lds, g, S, E); }  }
    SEAM(1);
    if (IN(2)) { TAIL_RES(0, DFF, ACT, W1D, SST + NTAIL * 32);
        { pg8::Gemm g{ACT, W1D, MAIN, DM, DFF}; pg8::StaticOrder S; S.init(MAIN, DM, G, bx); EpiRes<0> E{};
        pg8::gemm_phase<EpiRes<0>, pg8::StaticOrder, true, true, DFF, true>(lds, g, S, E); }  }
    SEAM(2);
    if (IN(3)) {
        if (bx >= G / 2) {
            LAS float* scr = (LAS float*)(lds + wave * 16384); const int hw = (bx - G / 2) * NWAVES + wave, NHW = (G - G / 2) * NWAVES;
            const KArgs ka = (KArgs)__builtin_amdgcn_kernarg_segment_ptr();
            for (int it = hw; it < 3 * I_G + I_OA + I_OP; it += NHW) conv_item(it < 3 * I_G ? it + 3 * I_G : it + 3 * I_G + I_IN, ka, scr, lane);
            const int ht = (bx - G / 2) * NTHR + tid, NHT = (G - G / 2) * NTHR;
            for (int i = ht; i < DB * 14 * (PW / 4); i += NHT) { const int q = i / (14 * (PW / 4)), rem = i - q * (14 * (PW / 4)); ((f32x4*)(out + O_PS))[(size_t)q * 15 * (PW / 4) + rem] = ((const f32x4*)state_pool)[(size_t)q * 15 * (PW / 4) + (PW / 4) + rem]; }
            for (int i0 = ht; i0 < DB * 127 * (KVW / 4); i0 += 4 * NHT) { f32x4 kk[4], vv[4]; size_t dd[4];
#pragma unroll
                for (int u = 0; u < 4; ++u) { int i = i0 + u * NHT; i = i < DB * 127 * (KVW / 4) ? i : DB * 127 * (KVW / 4) - 1; const int q = i / (127 * (KVW / 4)), rem = i - q * (127 * (KVW / 4)); dd[u] = (size_t)q * 128 * (KVW / 4) + rem;
                    kk[u] = ((const f32x4*)cache_k)[dd[u] + (KVW / 4)]; vv[u] = ((const f32x4*)cache_v)[dd[u] + (KVW / 4)]; }
#pragma unroll
                for (int u = 0; u < 4; ++u) { ((f32x4*)(out + O_KS))[dd[u]] = kk[u]; ((f32x4*)(out + O_VS))[dd[u]] = vv[u]; } }
            __syncthreads();
        }
        tail_rstd(SST + NTAIL * 32, lds, tid);
        for (int s3 = (bx >= G / 2) ? bx - G / 2 : 60; s3 < 60; s3 += G / 2) { const int su = s3 / 3, m0 = 3 * (s3 - 3 * su);
            const int kind = (su < 8) ? 3 : (su < 16) ? 0 : (su < 18) ? 1 : 2;
            const int hh = (kind == 3) ? su : (kind == 0) ? su - 8 : (kind == 1) ? su - 16 : su - 18;
            const int pn = (kind == 3) ? (hh >> 2) : (kind == 0) ? 2 + (hh >> 2) : 4, wc = (kind == 3) ? 0 : (kind == 0) ? (hh & 3) : (kind == 1) ? hh : 2 + hh;
#pragma unroll
            for (int p = 0; p < 2; ++p) { const int d0 = 32 * p + (lane & 15);
                const int r0 = (kind == 3) ? 64 * hh + d0 : win_row(pn, wc, d0), r1 = (kind == 3) ? 64 * hh + d0 + 16 : win_row(pn, wc, d0 + 16);
                skinny_pass<DM, 3>(XB + (size_t)TAIL0 * DM, WIN + (size_t)r0 * DM, WIN + (size_t)r1 * DM, lds, p ? T_R1 : T_R0, tid, wave, lane, m0); }
            const LAS float* RS = (const LAS float*)(lds + T_RS); const int d = lane; const LAS float* R = (const LAS float*)(lds + ((d < 32) ? T_R0 : T_R1)) + (d & 31);
            const float gain = (kind == 0) ? args.in[12][d] : (kind == 1) ? args.in[13][d] : 1.0f;
            for (int rrel = wave; rrel < 48; rrel += NWAVES) { const int row = 16 * m0 + rrel;
                float v = R[rrel * SLAB_P] * RS[row]; const size_t tr = (size_t)TAIL0 + row;
                if (kind == 3) { Ub[tr * PW + 64 * hh + d] = (bf16)(cvt_pk_bf16(v, 0.f) & 0xffffu); if (row >= NMETA) out[O_PS + ((size_t)(row - NMETA) * 15 + 14) * PW + 64 * hh + d] = v; }
                else {
                    if (kind < 2) { const float ssq = wave_sum(v * v); v = v * __builtin_amdgcn_rsqf(ssq * (1.0f / HD) + EPS) * gain;
                        const float pr = __shfl_xor(v, 8); const float* rp = ROPE + (size_t)((row < NMETA) ? row : TT) * 16 + (d & 7); const float cs = rp[0], sn = rp[8];
                        if (d < 8) v = v * cs - pr * sn; else if (d < 16) v = v * cs + pr * sn; }
                    if (kind == 0) Qb[tr * PW + 64 * hh + d] = (bf16)(cvt_pk_bf16(v, 0.f) & 0xffffu);
                    else { bf16* dstp = (kind == 1) ? Kb : Vb; dstp[tr * KVW + 64 * hh + d] = (bf16)(cvt_pk_bf16(v, 0.f) & 0xffffu);
                        if (row >= NMETA) out[((kind == 1) ? O_KS : O_VS) + ((size_t)(row - NMETA) * 128 + 127) * KVW + 64 * hh + d] = v; }
                }
            }
            __syncthreads();
        }
        { pg8::Gemm g{XB, WIN, MAIN, NIN, DM}; pg8::StaticOrder S; S.init(MAIN, NIN, G, bx); BUILD_RST(S); EpiIn E{RST};
        pg8::gemm_phase<EpiIn, pg8::StaticOrder, true, true, DM>(lds, g, S, E); } }
    SEAM(3);
    if (IN(4)) {
        constexpr int KPITCH = 144, KROWS = 192, KS_BYTES = 2 * KROWS * KPITCH, VS_OFF = KS_BYTES, PB_OFF = 2 * KS_BYTES;
        static_assert(PB_OFF <= RING_BYTES, "attention LDS");
        const float* sinks = args.in[14];
        constexpr int NPU = NB * 32;
        for (int ui0 = vcu; ui0 < NPU; ui0 += G) {
            const int ui = (G == 256) ? (((2 * (bx & 7) + (ui0 >> 8)) << 5) + (bx >> 3)) : ui0;
            const int b = ui >> 5, blk = ui & 31, t0 = 64 * blk + NMETA; const size_t rb = (size_t)b * SEQ;
            v4u kreg[6], vreg[6];
#pragma unroll
            for (int it = 0; it < 6; ++it) { const int ch = tid + it * NTHR, kk = ch >> 4, c16 = ch & 15; int p = t0 - 128 + kk; p = p < 0 ? 0 : p; const size_t row = (p >= NMETA) ? rb + (p - NMETA) : (size_t)TAIL0 + p;
                kreg[it] = *(const v4u*)(Kb + row * KVW + c16 * 8); vreg[it] = *(const v4u*)(Vb + row * KVW + c16 * 8); }
            unsigned xr[48];
            const int cp = tid & 255, rh = tid >> 8;
#pragma unroll
            for (int ii = 0; ii < 48; ++ii) { const int p = t0 + 32 * rh - 16 + ii; const size_t row = (p >= NMETA) ? rb + (p - NMETA) : (size_t)TAIL0 + p; xr[ii] = *(const unsigned*)(Ub + row * PW + 2 * cp); }
            const int h = wave, kvh = h >> 2, q = lane & 15, g = lane >> 4;
            bf16x8 qf[4][2];
#pragma unroll
            for (int j = 0; j < 4; ++j) { const bf16* qp = Qb + (rb + (t0 - NMETA) + 16 * j + q) * PW + 64 * h + 8 * g; qf[j][0] = *(const bf16x8*)(qp); qf[j][1] = *(const bf16x8*)(qp + 32); }
            { float xa[48], xb[48];
#pragma unroll
              for (int ii = 0; ii < 48; ++ii) { xa[ii] = __uint_as_float(xr[ii] << 16); xb[ii] = __uint_as_float(xr[ii] & 0xffff0000u); }
              bf16* mp = MIX + (rb + (t0 - NMETA) + 32 * rh) * DM + 2 * cp; const int wsel = cp >> 6;
#define POOL_W(W) { float Sa = 0.f, Sb = 0.f; _Pragma("unroll") for (int i = 16 - (W); i < 16; ++i) { Sa += xa[i]; Sb += xb[i]; } \
                _Pragma("unroll") for (int tt = 0; tt < 32; ++tt) { Sa += xa[16 + tt] - xa[16 + tt - (W)]; Sb += xb[16 + tt] - xb[16 + tt - (W)]; \
                    *(unsigned*)(mp + (size_t)tt * DM) = cvt_pk_bf16(Sa * (1.0f / (float)(W)) - xa[16 + tt], Sb * (1.0f / (float)(W)) - xb[16 + tt]); } }
              if (wsel == 0) POOL_W(2) else if (wsel == 1) POOL_W(4) else if (wsel == 2) POOL_W(8) else POOL_W(16)
#undef POOL_W
            }
#pragma unroll
            for (int it = 0; it < 6; ++it) { const int ch = tid + it * NTHR, kk = ch >> 4, c16 = ch & 15, kv = c16 >> 3, c8 = c16 & 7; const bool ok = (t0 - 128 + kk) >= 0;
                const v4u z4 = (v4u){0u, 0u, 0u, 0u}; const int off = (kv * KROWS + kk) * KPITCH + c8 * 16;
                *(LAS v4u*)(lds + off) = ok ? kreg[it] : z4; *(LAS v4u*)(lds + VS_OFF + off) = ok ? vreg[it] : z4; }
            __syncthreads();
            { const float sink = sinks[h] * 1.4426950408889634f;
              const LAS unsigned char* ksb = lds + (kvh * KROWS) * KPITCH; const LAS unsigned char* vsb = lds + VS_OFF + (kvh * KROWS) * KPITCH + (4 * g + ((lane >> 2) & 3)) * KPITCH + (lane & 3) * 8;
#pragma unroll
              for (int jp = 0; jp < 2; ++jp) {
                  f32x4 s[2][9]; float mx[2], l[2], rden[2];
#pragma unroll
                  for (int kt = 0; kt < 9; ++kt)
#pragma unroll
                      for (int jj = 0; jj < 2; ++jj) { const int j = 2 * jp + jj; const LAS unsigned char* kp = ksb + (16 * (j + kt) + q) * KPITCH + 16 * g;
                          const bf16x8 k0 = *(const LAS bf16x8*)(kp), k1 = *(const LAS bf16x8*)(kp + 64);
                          f32x4 a = (f32x4){0.f, 0.f, 0.f, 0.f}; a = __builtin_amdgcn_mfma_f32_16x16x32_bf16(k0, qf[j][0], a, 0, 0, 0); a = __builtin_amdgcn_mfma_f32_16x16x32_bf16(k1, qf[j][1], a, 0, 0, 0); s[jj][kt] = a; }
#pragma unroll
                  for (int jj = 0; jj < 2; ++jj) { const int tq0 = t0 + 16 * (2 * jp + jj), qpos = tq0 + q; float mxx = -1e30f;
#pragma unroll
                      for (int kt = 0; kt < 9; ++kt)
#pragma unroll
                          for (int e = 0; e < 4; ++e) { const int kp = tq0 - 128 + 16 * kt + 4 * g + e; const bool ok = (kp >= 0) && (kp <= qpos) && (kp > qpos - 128); const float v = ok ? s[jj][kt][e] * (0.125f * 1.4426950408889634f) : -1e30f; s[jj][kt][e] = v; mxx = fmaxf(mxx, v); }
                      mx[jj] = mxx; }
#pragma unroll
                  for (int jj = 0; jj < 2; ++jj) mx[jj] = fmaxf(mx[jj], __shfl_xor(mx[jj], 16));
#pragma unroll
                  for (int jj = 0; jj < 2; ++jj) mx[jj] = fmaxf(fmaxf(mx[jj], __shfl_xor(mx[jj], 32)), sink);
#pragma unroll
                  for (int jj = 0; jj < 2; ++jj) { float ll = 0.f;
#pragma unroll
                      for (int kt = 0; kt < 9; ++kt)
#pragma unroll
                          for (int e = 0; e < 4; ++e) { const float p = __builtin_amdgcn_exp2f(s[jj][kt][e] - mx[jj]); s[jj][kt][e] = p; ll += p; }
                      l[jj] = ll; }
#pragma unroll
                  for (int jj = 0; jj < 2; ++jj) l[jj] += __shfl_xor(l[jj], 16);
#pragma unroll
                  for (int jj = 0; jj < 2; ++jj) { l[jj] += __shfl_xor(l[jj], 32); rden[jj] = __builtin_amdgcn_rcpf(l[jj] + __builtin_amdgcn_exp2f(sink - mx[jj])); }
                  f32x4 o[2][4];
#pragma unroll
                  for (int jj = 0; jj < 2; ++jj)
#pragma unroll
                      for (int dt = 0; dt < 4; ++dt) o[jj][dt] = (f32x4){0.f, 0.f, 0.f, 0.f};
#pragma unroll
                  for (int s2 = 0; s2 < 5; ++s2)
#pragma unroll
                      for (int jj = 0; jj < 2; ++jj) { const int j = 2 * jp + jj;
                          v4u pw; pw.x = cvt_pk_bf16(s[jj][2 * s2][0], s[jj][2 * s2][1]); pw.y = cvt_pk_bf16(s[jj][2 * s2][2], s[jj][2 * s2][3]);
                          if (s2 < 4) { pw.z = cvt_pk_bf16(s[jj][2 * s2 + 1][0], s[jj][2 * s2 + 1][1]); pw.w = cvt_pk_bf16(s[jj][2 * s2 + 1][2], s[jj][2 * s2 + 1][3]); } else { pw.z = 0u; pw.w = 0u; }
                          const bf16x8 pf = __builtin_bit_cast(bf16x8, pw);
#pragma unroll
                          for (int dt = 0; dt < 4; ++dt) { const LAS unsigned char* vp = vsb + (16 * (j + 2 * s2)) * KPITCH + dt * 32;
                              const s16x4 va = vtr(vp), vb = vtr(vp + ((s2 < 4) ? 16 * KPITCH : 0)); const bf16x8 vf = (bf16x8){va[0], va[1], va[2], va[3], vb[0], vb[1], vb[2], vb[3]};
                              o[jj][dt] = __builtin_amdgcn_mfma_f32_16x16x32_bf16(vf, pf, o[jj][dt], 0, 0, 0); } }
#pragma unroll
                  for (int jj = 0; jj < 2; ++jj) { bf16* op = MIX + (rb + (t0 + 16 * (2 * jp + jj) - NMETA) + q) * DM + PW + 64 * h + 4 * g;
#pragma unroll
                      for (int dt = 0; dt < 4; ++dt) { v2u w; w.x = cvt_pk_bf16(o[jj][dt][0] * rden[jj], o[jj][dt][1] * rden[jj]); w.y = cvt_pk_bf16(o[jj][dt][2] * rden[jj], o[jj][dt][3] * rden[jj]); *(v2u*)(op + 16 * dt) = w; } }
              } }
            __syncthreads();
        }
        for (int su = vcu; su < 2 * DB; su += G) {
            const int i = su >> 1, kv = su & 1; const size_t r = (size_t)TAIL0 + NMETA + i;
            f32x4 kr4[4], vr4[4];
#pragma unroll
            for (int it = 0; it < 4; ++it) { int ch = tid + it * NTHR; ch = ch < 2032 ? ch : 2031; const int row = ch >> 4, c = ch & 15; const size_t off = ((size_t)i * 128 + row + 1) * KVW + 64 * kv + 4 * c;
                kr4[it] = *(const f32x4*)(cache_k + off); vr4[it] = *(const f32x4*)(cache_v + off); }
            v4u knew = (v4u){0u, 0u, 0u, 0u}, vnew = (v4u){0u, 0u, 0u, 0u};
            if (tid < 8) { knew = *(const v4u*)(Kb + r * KVW + 64 * kv + 8 * tid); vnew = *(const v4u*)(Vb + r * KVW + 64 * kv + 8 * tid); }
            if (kv == 0) {
                const int c = tid, w = 2 << (c >> 7); const float cur = bf2f(Ub[r * PW + c]); const float* sp = state_pool + (size_t)i * 15 * PW + c; float xs[15];
#pragma unroll
                for (int k = 0; k < 15; ++k) xs[k] = sp[(size_t)k * PW];
                float S = cur;
#pragma unroll
                for (int k = 0; k < 15; ++k) S += (k >= 16 - w) ? xs[k] : 0.f;
                const float d = S / (float)w - cur; MIX[r * DM + c] = (bf16)(cvt_pk_bf16(d, 0.f) & 0xffffu);
            }
#pragma unroll
            for (int it = 0; it < 4; ++it) { const int ch = tid + it * NTHR; if (ch < 2032) { const int row = ch >> 4, c = ch & 15, off = row * KPITCH + c * 8;
                v2u a; a.x = cvt_pk_bf16(kr4[it].x, kr4[it].y); a.y = cvt_pk_bf16(kr4[it].z, kr4[it].w); *(LAS v2u*)(lds + off) = a;
                v2u bq; bq.x = cvt_pk_bf16(vr4[it].x, vr4[it].y); bq.y = cvt_pk_bf16(vr4[it].z, vr4[it].w); *(LAS v2u*)(lds + VS_OFF + off) = bq; } }
            if (tid < 8) { *(LAS v4u*)(lds + 127 * KPITCH + tid * 16) = knew; *(LAS v4u*)(lds + VS_OFF + 127 * KPITCH + tid * 16) = vnew; }
            __syncthreads();
            if (wave == 0) {
                const int q = lane & 15, g = lane >> 4, hq = 4 * kv + (q & 3); const float sink = sinks[hq] * 1.4426950408889634f;
                const bf16* qp = Qb + r * PW + 64 * hq + 8 * g; const bf16x8 qf0 = *(const bf16x8*)(qp), qf1 = *(const bf16x8*)(qp + 32);
                const LAS unsigned char* vsb = lds + VS_OFF + (4 * g + ((lane >> 2) & 3)) * KPITCH + (lane & 3) * 8;
                f32x4 s[8]; float mx = -1e30f;
#pragma unroll
                for (int kt = 0; kt < 8; ++kt) { const LAS unsigned char* kp = lds + (16 * kt + q) * KPITCH + 16 * g;
                    const bf16x8 k0 = *(const LAS bf16x8*)(kp), k1 = *(const LAS bf16x8*)(kp + 64);
                    f32x4 a = (f32x4){0.f, 0.f, 0.f, 0.f}; a = __builtin_amdgcn_mfma_f32_16x16x32_bf16(k0, qf0, a, 0, 0, 0); a = __builtin_amdgcn_mfma_f32_16x16x32_bf16(k1, qf1, a, 0, 0, 0);
                    a = a * (0.125f * 1.4426950408889634f); s[kt] = a; mx = fmaxf(fmaxf(mx, fmaxf(a[0], a[1])), fmaxf(a[2], a[3])); }
                mx = fmaxf(mx, __shfl_xor(mx, 16)); mx = fmaxf(mx, __shfl_xor(mx, 32)); mx = fmaxf(mx, sink);
                float l = 0.f;
#pragma unroll
                for (int kt = 0; kt < 8; ++kt)
#pragma unroll
                    for (int e = 0; e < 4; ++e) { const float p = __builtin_amdgcn_exp2f(s[kt][e] - mx); s[kt][e] = p; l += p; }
                l += __shfl_xor(l, 16); l += __shfl_xor(l, 32);
                const float rden = __builtin_amdgcn_rcpf(l + __builtin_amdgcn_exp2f(sink - mx));
                f32x4 o[4];
#pragma unroll
                for (int dt = 0; dt < 4; ++dt) o[dt] = (f32x4){0.f, 0.f, 0.f, 0.f};
#pragma unroll
                for (int s2 = 0; s2 < 4; ++s2) {
                    v4u pw; pw.x = cvt_pk_bf16(s[2 * s2][0], s[2 * s2][1]); pw.y = cvt_pk_bf16(s[2 * s2][2], s[2 * s2][3]); pw.z = cvt_pk_bf16(s[2 * s2 + 1][0], s[2 * s2 + 1][1]); pw.w = cvt_pk_bf16(s[2 * s2 + 1][2], s[2 * s2 + 1][3]);
                    const bf16x8 pf = __builtin_bit_cast(bf16x8, pw);
#pragma unroll
                    for (int dt = 0; dt < 4; ++dt) { const LAS unsigned char* vp = vsb + (32 * s2) * KPITCH + dt * 32;
                        const s16x4 va = vtr(vp), vb = vtr(vp + 16 * KPITCH); const bf16x8 vf = (bf16x8){va[0], va[1], va[2], va[3], vb[0], vb[1], vb[2], vb[3]};
                        o[dt] = __builtin_amdgcn_mfma_f32_16x16x32_bf16(vf, pf, o[dt], 0, 0, 0); }
                }
                if (q < 4) { bf16* op = MIX + r * DM + PW + 64 * hq + 4 * g;
#pragma unroll
                    for (int dt = 0; dt < 4; ++dt) { v2u w; w.x = cvt_pk_bf16(o[dt][0] * rden, o[dt][1] * rden); w.y = cvt_pk_bf16(o[dt][2] * rden, o[dt][3] * rden); *(v2u*)(op + 16 * dt) = w; } }
            }
            __syncthreads();
        }
        for (int i = vcu * NTHR + tid; i < NMETA * (DM / 8); i += G * NTHR) ((v4u*)(MIX + (size_t)TAIL0 * DM))[i] = (v4u){0u, 0u, 0u, 0u};
    }
    SEAM(4);
    if (IN(5)) { TAIL_RES(1, DM, MIX, WOUT, SST + 2 * NTAIL * 32);
        { pg8::Gemm g{MIX, WOUT, MAIN, DM, DM}; pg8::StaticOrder S; S.init(MAIN, DM, G, bx); EpiRes<1> E{};
        pg8::gemm_phase<EpiRes<1>, pg8::StaticOrder, true, true, DM>(lds, g, S, E); }  }
    SEAM(5);
    if (IN(6)) { TAIL_SWIGLU(W2GU, SST + 2 * NTAIL * 32);
        { pg8::Gemm g{XB, W2GU, MAIN, NGU, DM}; pg8::StaticOrder S; S.init(MAIN, NGU, G, bx); BUILD_RST(S); EpiSwiGLU E{RST};
        pg8::gemm_phase<EpiSwiGLU, pg8::StaticOrder, true, true, DM>(lds, g, S, E); }  }
    SEAM(6);
    if (IN(7)) { TAIL_RES(2, DFF, ACT, W2D, SST);
        { pg8::Gemm g{ACT, W2D, MAIN, DM, DFF}; pg8::StaticOrder S; S.init(MAIN, DM, G, bx); EpiRes<2> E{};
        pg8::gemm_phase<EpiRes<2>, pg8::StaticOrder, true, true, DFF, true>(lds, g, S, E); }  }
#undef IN
#undef SEAM
}

extern "C" void kernel_launch(void* const* d_in, const int* in_sizes, int n_in, void* d_out, int out_size, void* d_ws, size_t ws_size, hipStream_t stream) {
    static int grid = 0;
    if (grid == 0) {
        if (n_in != 22 || (size_t)out_size != O_END || ws_size < WS_END) { fprintf(stderr, "kernel_launch: unexpected shapes: n_in %d out %d ws %zu (need %zu)\n", n_in, out_size, ws_size, (size_t)WS_END); grid = -1; return; }
        int dev = 0, cus = 0, per_cu = 0;
        if (hipGetDevice(&dev) != hipSuccess || hipDeviceGetAttribute(&cus, hipDeviceAttributeMultiprocessorCount, dev) != hipSuccess) { grid = -1; return; }
        if (hipFuncSetAttribute((const void*)hymba_fwd, hipFuncAttributeMaxDynamicSharedMemorySize, LDS_BYTES) != hipSuccess) { fprintf(stderr, "kernel_launch: hipFuncSetAttribute failed\n"); grid = -1; return; }
        if (hipOccupancyMaxActiveBlocksPerMultiprocessor(&per_cu, (const void*)hymba_fwd, NTHR, LDS_BYTES) != hipSuccess || per_cu < 1) { fprintf(stderr, "kernel_launch: occupancy query says %d\n", per_cu); per_cu = 1; }
        (void)hipGetLastError();
        grid = cus * 1;
    }
    if (grid < 0) return;
    if (hipMemsetAsync((char*)d_ws + WS_CTL, 0, 65536, stream) != hipSuccess) { fprintf(stderr, "kernel_launch: memset failed\n"); return; }
    Args a{};
    for (int i = 0; i < 22; ++i) a.in[i] = (const float*)d_in[i];
    a.out = (float*)d_out; a.ws = (unsigned char*)d_ws;
    for (int i = 0; i < 8; ++i) { const float e = (float)(-13.122363377404328) * (float)i * 0.125f; a.invf[i] = (float)std::exp((double)e); }
#if MK_N_LAUNCHES == 1
    a.ph_lo = 0; a.ph_hi = 8;
    void* kargs[] = {&a};
    const hipError_t e = hipLaunchCooperativeKernel((const void*)hymba_fwd, dim3(grid), dim3(NTHR), kargs, LDS_BYTES, stream);
    if (e != hipSuccess) fprintf(stderr, "kernel_launch: cooperative launch failed: %s (grid %d)\n", hipGetErrorString(e), grid);
#ifdef PROBE_PHASE
    a.ph_lo = PROBE_PHASE; a.ph_hi = PROBE_PHASE + 1; hipLaunchKernelGGL(hymba_fwd, dim3(grid), dim3(NTHR), LDS_BYTES, stream, a);
#endif
#else
    for (int p = 0; p < 8; ++p) { a.ph_lo = p; a.ph_hi = p + 1; hipLaunchKernelGGL(hymba_fwd, dim3(grid), dim3(NTHR), LDS_BYTES, stream, a); }
#endif
}
```

```cpp
#include <hip/hip_runtime.h>
#include <hip/hip_cooperative_groups.h>
#include <cstdio>
#include <cstdint>
#include <cmath>
namespace cg = cooperative_groups;
namespace pg8 {
#define PG8_LAS __attribute__((address_space(3)))
typedef unsigned short bf16_t;
typedef short bf16x8 __attribute__((ext_vector_type(8)));
typedef float f32x4 __attribute__((ext_vector_type(4)));
typedef unsigned u32x4 __attribute__((ext_vector_type(4)));
constexpr int BM = 256, BK = 64, HALF = 128, HTB = HALF * BK * 2  , STAGE_BYTES = 8 * HTB, NXCD = 8, WGM = 4;

__host__ __device__ __forceinline__ int lds_byte(int r, int c) { const int st = (r >> 4) * 2 + (c >> 5), rr = r & 15, cc = c & 31, ob = rr * 64 + cc * 2; return st * 1024 + (ob ^ (((ob >> 9) & 1) << 5)); }
__host__ __device__ __forceinline__ void stage_rc(int b, int& R, int& C) { const int st = b / 1024, sb = b % 1024, swz = sb ^ (((sb >> 9) & 1) << 5); R = (st >> 1) * 16 + swz / 64; C = (st & 1) * 32 + (swz % 64) / 2; }
__host__ __device__ __forceinline__ int perm32(int rho) { const int n = rho >> 4, i = rho & 15; return 8 * (i >> 2) + 4 * n + (i & 3); }

struct Unit { int pm, pn, ui; };
struct Gemm { const bf16_t* A; const bf16_t* Bt; int M, N, K; };

struct StaticOrder {
    int nM, nN, nwg, G, c;
    __host__ __device__ void init(int M, int N, int G_, int c_) { nM = M / BM; nN = N / BM; nwg = nM * nN; G = G_; c = c_; }
    __host__ __device__ bool next(int i, Unit& u) const {
        const long L = (long)i * G + c; if (L >= nwg) return false;
        int wgid = (int)L; { const int q = nwg / NXCD, r = nwg % NXCD, xcd = wgid % NXCD, off = wgid / NXCD; wgid = (xcd < r ? xcd * (q + 1) : r * (q + 1) + (xcd - r) * q) + off; }
        const int nig = WGM * nN, gid = wgid / nig, fm = gid * WGM, gsz = (nM - fm) < WGM ? (nM - fm) : WGM;
        u.pm = fm + ((wgid % nig) % gsz); u.pn = (wgid % nig) / gsz; u.ui = i; return true;
    }
    __device__ __forceinline__ void a_ready(const Unit&) const {}
    __device__ __forceinline__ void done(const Unit&) const {}
};

__device__ __forceinline__ unsigned cvt_pk_bf16(float lo, float hi) { unsigned r; asm volatile("v_cvt_pk_bf16_f32 %0, %1, %2" : "=v"(r) : "v"(lo), "v"(hi)); return r; }
typedef float f32x2 __attribute__((ext_vector_type(2)));
template <class Epi, class Sched, bool ALIGN_EPI, bool SP2, int KC, bool ATILED = false, bool BTILED = false>
__device__ __forceinline__ void gemm_phase(PG8_LAS unsigned char* lds, const Gemm g, const Sched& S, const Epi& E) {
    const int tid = threadIdx.x, wid = __builtin_amdgcn_readfirstlane(tid >> 6), lane = tid & 63, wr = wid >> 2, wc = wid & 3, fr = lane & 15, fq = lane >> 4;
    constexpr int K = KC, nt = K / BK;
    unsigned voffA[2], voffB[2];
#pragma unroll
    for (int i = 0; i < 2; ++i) { int R, C; stage_rc(tid * 16 + i * 8192, R, C); const int Rb = Epi::PERM ? ((R & ~31) + perm32(R & 31)) : R;
        voffA[i] = (unsigned)(R * (ATILED ? BK : K) + C) * 2u; voffB[i] = (unsigned)(Rb * (BTILED ? BK : K) + C) * 2u; }
    const size_t kstep = (size_t)(BK * 2);
    const size_t kstepA = ATILED ? (size_t)(BM * BK * 2) : kstep, hstepA = ATILED ? (size_t)(HALF * BK * 2) : (size_t)HALF * K * 2;
    const size_t kstepB = BTILED ? (size_t)(BM * BK * 2) : kstep, hstepB = BTILED ? (size_t)(HALF * BK * 2) : (size_t)HALF * K * 2;
    const size_t hstep = (size_t)HALF * K * 2;
    const size_t tstep = 2 * hstep;
    const unsigned ldsw = (unsigned)wid * 1024u;
    const int aoff = lds_byte(wr * 64 + fr, fq * 8), boff = lds_byte(wc * 32 + fr, fq * 8);
#define PG8_SA(b, h) (((b) * 2 + (h)) * HTB)
#define PG8_SB(b, h) ((4 + (b) * 2 + (h)) * HTB)
#define PG8_STAGE(bufoff, gbase, voff) do { _Pragma("unroll") for (int _i = 0; _i < 2; ++_i) \
        __builtin_amdgcn_global_load_lds((const unsigned*)((const char*)(gbase) + (voff)[_i]), (PG8_LAS unsigned*)(lds + (bufoff) + ldsw + _i * 8192), 16, 0, 0); } while (0)
#define PG8_LDA(dst, b, h) do { _Pragma("unroll") for (int m = 0; m < 4; ++m) _Pragma("unroll") for (int k = 0; k < 2; ++k) dst[m][k] = *(const PG8_LAS bf16x8*)(lds + PG8_SA(b, h) + aoff + m * 2048 + k * 1024); } while (0)
#define PG8_LDB(dst, b, h) do { _Pragma("unroll") for (int n = 0; n < 2; ++n) _Pragma("unroll") for (int k = 0; k < 2; ++k) dst[n][k] = *(const PG8_LAS bf16x8*)(lds + PG8_SB(b, h) + boff + n * 2048 + k * 1024); } while (0)
#define PG8_MMA(ai, bj, At, Bt) do { __builtin_amdgcn_s_setprio(1); _Pragma("unroll") for (int m = 0; m < 4; ++m) _Pragma("unroll") for (int n = 0; n < 2; ++n) _Pragma("unroll") for (int k = 0; k < 2; ++k) \
        acc[ai][bj][m][n] = __builtin_amdgcn_mfma_f32_16x16x32_bf16(Bt[n][k], At[m][k], acc[ai][bj][m][n], 0, 0, 0); __builtin_amdgcn_s_setprio(0); } while (0)
#define PG8_WAIT_V(n) asm volatile("s_waitcnt vmcnt(" #n ")" ::: "memory")
#define PG8_WAIT_L(n) asm volatile("s_waitcnt lgkmcnt(" #n ")" ::: "memory")
#define PG8_BAR __builtin_amdgcn_s_barrier()
#define PG8_SCHED __builtin_amdgcn_sched_barrier(0)
    Unit cur, nxt; int ui = 0;
    if (!S.next(0, cur)) return;
    f32x4 acc[2][2][4][2];
#pragma unroll
    for (int a = 0; a < 2; ++a)
#pragma unroll
        for (int b = 0; b < 2; ++b)
#pragma unroll
            for (int m = 0; m < 4; ++m)
#pragma unroll
                for (int n = 0; n < 2; ++n) acc[a][b][m][n] = (f32x4){0.f, 0.f, 0.f, 0.f};
    bf16x8 At[4][2], B0[2][2], B1[2][2];
    const char* cA = (const char*)g.A + (size_t)cur.pm * tstep; const char* cB = (const char*)g.Bt + (size_t)cur.pn * tstep;
    S.a_ready(cur);
    if constexpr (SP2) {
        PG8_STAGE(PG8_SB(0, 0), cB, voffB); PG8_STAGE(PG8_SB(0, 1), cB + hstepB, voffB); PG8_STAGE(PG8_SA(0, 0), cA, voffA); PG8_STAGE(PG8_SA(0, 1), cA + hstepA, voffA);
        if (wr == 1) PG8_BAR;
        PG8_WAIT_V(2); PG8_BAR;
        PG8_STAGE(PG8_SB(1, 0), cB + kstepB, voffB); PG8_STAGE(PG8_SA(1, 0), cA + kstepA, voffA); PG8_STAGE(PG8_SB(1, 1), cB + hstepB + kstepB, voffB);
        PG8_WAIT_V(6); PG8_BAR;
    } else {
        PG8_STAGE(PG8_SB(0, 0), cB, voffB); PG8_STAGE(PG8_SA(0, 0), cA, voffA); PG8_STAGE(PG8_SB(0, 1), cB + hstepB, voffB); PG8_STAGE(PG8_SA(0, 1), cA + hstepA, voffA);
        if (wr == 1) PG8_BAR;
        PG8_WAIT_V(4); PG8_BAR;
        PG8_STAGE(PG8_SB(1, 0), cB + kstepB, voffB); PG8_STAGE(PG8_SA(1, 0), cA + kstepA, voffA); PG8_STAGE(PG8_SB(1, 1), cB + hstepB + kstepB, voffB);
        PG8_WAIT_V(6); PG8_BAR;
    }
    for (;;) {
        const bool has_next = S.next(ui + 1, nxt);
        const char* nA = has_next ? (const char*)g.A + (size_t)nxt.pm * tstep : cA; const char* nB = has_next ? (const char*)g.Bt + (size_t)nxt.pn * tstep : cB;
        for (int t = 0; t < nt; t += 2) {
            const bool last = (t == nt - 2);
            const char* a1 = cA + (size_t)(t + 1) * kstepA;
            const char* a2 = last ? nA : cA + (size_t)(t + 2) * kstepA; const char* b2 = last ? nB : cB + (size_t)(t + 2) * kstepB;
            const char* a3 = a2 + kstepA; const char* b3 = b2 + kstepB;
            if (last && has_next) S.a_ready(nxt);
            if constexpr (SP2) {
            PG8_LDB(B0, 0, 0); PG8_LDB(B1, 0, 1); PG8_SCHED; PG8_LDA(At, 0, 0); PG8_STAGE(PG8_SA(1, 1), a1 + hstepA, voffA);
            PG8_WAIT_V(8); PG8_WAIT_L(0); PG8_BAR; PG8_MMA(0, 0, At, B0); PG8_MMA(0, 1, At, B1); PG8_BAR; PG8_SCHED;
            PG8_LDA(At, 0, 1); PG8_STAGE(PG8_SB(0, 0), b2, voffB); PG8_STAGE(PG8_SB(0, 1), b2 + hstepB, voffB); PG8_STAGE(PG8_SA(0, 0), a2, voffA);
            PG8_WAIT_V(8); PG8_WAIT_L(0); PG8_BAR; PG8_MMA(1, 0, At, B0); PG8_MMA(1, 1, At, B1); PG8_BAR; PG8_SCHED;
            PG8_LDB(B0, 1, 0); PG8_LDB(B1, 1, 1); PG8_SCHED; PG8_LDA(At, 1, 0); PG8_STAGE(PG8_SA(0, 1), a2 + hstepA, voffA);
            PG8_WAIT_V(8); PG8_WAIT_L(0); PG8_BAR; PG8_MMA(0, 0, At, B0); PG8_MMA(0, 1, At, B1); PG8_BAR; PG8_SCHED;
            PG8_LDA(At, 1, 1); PG8_STAGE(PG8_SB(1, 0), b3, voffB); PG8_STAGE(PG8_SB(1, 1), b3 + hstepB, voffB); PG8_STAGE(PG8_SA(1, 0), a3, voffA);
            PG8_WAIT_V(8); PG8_WAIT_L(0); PG8_BAR; PG8_MMA(1, 0, At, B0); PG8_MMA(1, 1, At, B1); PG8_BAR; PG8_SCHED;
            } else {
            PG8_LDB(B0, 0, 0); PG8_SCHED; PG8_LDA(At, 0, 0); PG8_STAGE(PG8_SA(1, 1), a1 + hstepA, voffA);
            PG8_WAIT_L(8); PG8_BAR; PG8_WAIT_L(0); PG8_MMA(0, 0, At, B0); PG8_BAR; PG8_SCHED;
            PG8_LDB(B1, 0, 1); PG8_STAGE(PG8_SB(0, 0), b2, voffB);
            PG8_BAR; PG8_WAIT_L(0); PG8_MMA(0, 1, At, B1); PG8_BAR;
            PG8_LDA(At, 0, 1); PG8_STAGE(PG8_SA(0, 0), a2, voffA);
            PG8_BAR; PG8_WAIT_L(0); PG8_MMA(1, 0, At, B0); PG8_BAR; PG8_SCHED;
            PG8_STAGE(PG8_SB(0, 1), b2 + hstepB, voffB);
            PG8_WAIT_V(6); PG8_BAR; PG8_MMA(1, 1, At, B1); PG8_BAR;
            PG8_LDB(B0, 1, 0); PG8_SCHED; PG8_LDA(At, 1, 0); PG8_STAGE(PG8_SA(0, 1), a2 + hstepA, voffA);
            PG8_WAIT_L(8); PG8_BAR; PG8_WAIT_L(0); PG8_MMA(0, 0, At, B0); PG8_BAR; PG8_SCHED;
            PG8_LDB(B1, 1, 1); PG8_STAGE(PG8_SB(1, 0), b3, voffB);
            PG8_BAR; PG8_WAIT_L(0); PG8_MMA(0, 1, At, B1); PG8_BAR;
            PG8_LDA(At, 1, 1); PG8_STAGE(PG8_SA(1, 0), a3, voffA);
            PG8_BAR; PG8_WAIT_L(0); PG8_MMA(1, 0, At, B0); PG8_BAR; PG8_SCHED;
            PG8_STAGE(PG8_SB(1, 1), b3 + hstepB, voffB);
            PG8_WAIT_V(6); PG8_BAR; PG8_MMA(1, 1, At, B1); PG8_BAR;
            }
        }
        if constexpr (ALIGN_EPI) { if (wr == 0) PG8_BAR; }
        if constexpr (!Epi::AFTER_DRAIN) { E(acc, cur, wr, wc, fr, fq); S.done(cur); }
        if (!has_next) break;
#pragma unroll
        for (int a = 0; a < 2; ++a)
#pragma unroll
            for (int b = 0; b < 2; ++b)
#pragma unroll
                for (int m = 0; m < 4; ++m)
#pragma unroll
                    for (int n = 0; n < 2; ++n) acc[a][b][m][n] = (f32x4){0.f, 0.f, 0.f, 0.f};
        cur = nxt; cA = nA; cB = nB; ++ui;
        if constexpr (ALIGN_EPI) { if (wr == 1) PG8_BAR; }
    }
    PG8_WAIT_V(0);
    if constexpr (!ALIGN_EPI) { if (wr == 0) PG8_BAR; }
    PG8_BAR;
    if constexpr (Epi::AFTER_DRAIN) { E.fused(acc, cur, wr, wc, fr, fq, lds, wid, lane); S.done(cur); }
#undef PG8_SA
#undef PG8_SB
#undef PG8_STAGE
#undef PG8_LDA
#undef PG8_LDB
#undef PG8_MMA
#undef PG8_WAIT_V
#undef PG8_WAIT_L
#undef PG8_BAR
#undef PG8_SCHED
}
}

#ifndef MK_N_LAUNCHES
#define MK_N_LAUNCHES 1
#endif
constexpr int NWAVES = 8, NTHR = 512;
constexpr int DM = 1024, NB = 16, SEQ = 2048, NMETA = 16, TT = SEQ + NMETA, DB = 128;
constexpr int MAIN = NB * SEQ;
constexpr int TAIL0 = MAIN, NTAIL = 144;
constexpr int MPAD = 33024;
constexpr int DFF = 2816, NGU = 2 * DFF, NIN = 1280, PW = 512, NH = 8, HD = 64, KVW = 128;
constexpr int PASTLEN = 16384, NPOS = TT + 1;
constexpr float EPS = 1e-6f;
constexpr size_t O_Y = 0, O_YS = 33554432, O_PP = 33685504, O_KP = 33808384, O_VP = 34070528, O_PS = 34332672, O_KS = 35315712, O_VS = 37412864, O_END = 39510016;
constexpr size_t MiB = 1u << 20;
constexpr size_t WS_CTL = 0, WS_ROPE = 1 * MiB, WS_SS = 2 * MiB, WS_SST = 4 * MiB + 65536, WS_W1GU = 5 * MiB, WS_W1D = 16 * MiB, WS_WIN = 22 * MiB, WS_WOUT = 25 * MiB, WS_W2GU = 27 * MiB, WS_W2D = 38 * MiB,
                 WS_XB = 44 * MiB, WS_X = 109 * MiB, WS_ACT = 239 * MiB, WS_U = 239 * MiB, WS_Q = 272 * MiB, WS_K = 305 * MiB, WS_V = 314 * MiB, WS_MIX = 323 * MiB, WS_END = 418 * MiB;
static_assert(WS_SS + (size_t)MAIN * 16 * 4 <= WS_SST && WS_SST + 3 * NTAIL * 32 * 4 <= WS_W1GU && WS_XB + (size_t)MPAD * DM * 2 <= WS_X && WS_X + (size_t)MPAD * DM * 4 <= WS_ACT && WS_ACT + (size_t)MPAD * DFF * 2 <= WS_END, "ws map");
static_assert(WS_U + (size_t)MPAD * PW * 2 <= WS_Q && WS_Q + (size_t)MPAD * PW * 2 <= WS_K && WS_K + (size_t)MPAD * KVW * 2 <= WS_V && WS_V + (size_t)MPAD * KVW * 2 <= WS_MIX && WS_MIX + (size_t)MPAD * DM * 2 <= WS_END, "ws overlay");
constexpr int RING_BYTES = 131072, LDS_BYTES = 147456;

#define LAS __attribute__((address_space(3)))
typedef unsigned short bf16;
typedef unsigned v4u __attribute__((ext_vector_type(4)));
typedef unsigned v2u __attribute__((ext_vector_type(2)));
typedef float f32x4 __attribute__((ext_vector_type(4)));
typedef short bf16x8 __attribute__((ext_vector_type(8)));
typedef short s16x4 __attribute__((ext_vector_type(4)));
#define LDS_WAIT() asm volatile("s_waitcnt lgkmcnt(0)" ::: "memory")
#define RLX_AGENT __ATOMIC_RELAXED, __HIP_MEMORY_SCOPE_AGENT
#define XB_TMO      128
#define XB_XCNT(j)  (256  + 64 * (j))
#define XB_XSUB(j)  (1280 + 64 * (j))
#define XB_XGEN(j)  (2304 + 64 * (j))
#define XB_TOP      3328
#define XB_TOPGEN   3392
#define XCD_BAR_WORDS 3456
#define XB_SPIN_CAP (1u << 18)

__device__ __forceinline__ unsigned xb_ld(unsigned* p)              { return __hip_atomic_load(p, __ATOMIC_RELAXED, __HIP_MEMORY_SCOPE_AGENT); }
__device__ __forceinline__ unsigned xb_add(unsigned* p, unsigned v) { return __hip_atomic_fetch_add(p, v, __ATOMIC_RELAXED, __HIP_MEMORY_SCOPE_AGENT); }
__device__ __forceinline__ unsigned xb_xcc_id() { return (unsigned)__builtin_amdgcn_s_getreg((3 << 11) | 20) & 0xFu; }
#define XB_SPIN(cond, bar) do { unsigned _sp = 0; while (cond) { __builtin_amdgcn_s_sleep(1); \
    if ((++_sp & 255u) == 0u) { if (xb_ld(&(bar)[XB_TMO])) break; if (_sp > XB_SPIN_CAP) { atomicAdd(&(bar)[XB_TMO], 1u); break; } } } } while (0)

struct XcdBarrier {
    unsigned* bar; unsigned x;
    volatile LAS unsigned* st;
};

__device__ __forceinline__ XcdBarrier xcd_barrier_post(unsigned* bar, volatile LAS unsigned* st) {
    XcdBarrier b; b.bar = bar; b.x = xb_xcc_id(); b.st = st;
    if (threadIdx.x == 0) (void)xb_add(&bar[XB_XCNT(b.x)], 1u);
    return b;
}
__device__ __forceinline__ void xcd_barrier_complete(unsigned* bar, unsigned x, unsigned& nloc, unsigned& nx) {
    const unsigned G = gridDim.x * gridDim.y * gridDim.z;
    unsigned sum, cnt, mine, sp = 0u;
    for (;;) {
        sum = 0u; cnt = 0u; mine = 0u;
#pragma unroll
        for (unsigned j = 0; j < 16; ++j) { const unsigned c = xb_ld(&bar[XB_XCNT(j)]); sum += c; cnt += (c > 0u) ? 1u : 0u; mine = (j == x) ? c : mine; }
        if (sum == G) break;
        __builtin_amdgcn_s_sleep(1);
        if ((++sp & 255u) == 0u) { if (xb_ld(&bar[XB_TMO])) break; if (sp > XB_SPIN_CAP) { atomicAdd(&bar[XB_TMO], 1u); break; } }
    }
    nloc = mine > 0u ? mine : 1u; nx = cnt > 0u ? cnt : 1u;
}

__device__ __forceinline__ void xcd_barrier(const XcdBarrier& b) {
    asm volatile("s_waitcnt vmcnt(0)" ::: "memory");
    __syncthreads();
    if (threadIdx.x == 0) {
        unsigned* bar = b.bar;
        __builtin_amdgcn_s_waitcnt(0);
        unsigned nloc = b.st[0], nx = b.st[1];
        if (nloc == 0u) { xcd_barrier_complete(bar, b.x, nloc, nx); b.st[0] = nloc; b.st[1] = nx; }
        const unsigned old = xb_add(&bar[XB_XSUB(b.x)], 1u);
        const unsigned gen = old / nloc;
        if (old + 1u == (gen + 1u) * nloc) {
            __builtin_amdgcn_fence(__ATOMIC_RELEASE, "agent");
            asm volatile("s_waitcnt vmcnt(0)" ::: "memory");
            const unsigned og = xb_add(&bar[XB_TOP], 1u);
            const unsigned tg = og / nx;
            if (og + 1u == (tg + 1u) * nx) xb_add(&bar[XB_TOPGEN], 1u);
            else XB_SPIN(xb_ld(&bar[XB_TOPGEN]) == tg, bar);
            __builtin_amdgcn_fence(__ATOMIC_ACQUIRE, "agent");
            xb_add(&bar[XB_XGEN(b.x)], 1u);
            asm volatile("s_waitcnt vmcnt(0)" ::: "memory");
        } else {
            XB_SPIN(xb_ld(&bar[XB_XGEN(b.x)]) == gen, bar);
            __builtin_amdgcn_fence(__ATOMIC_ACQUIRE, "agent");
            asm volatile("s_waitcnt vmcnt(0)" ::: "memory");
        }
    }
    __syncthreads();
}


using pg8::cvt_pk_bf16;
typedef short v4i16_t __attribute__((ext_vector_type(4)));
__device__ __forceinline__ s16x4 vtr(const LAS unsigned char* p) { return __builtin_bit_cast(s16x4, __builtin_amdgcn_ds_read_tr16_b64_v4i16((LAS v4i16_t*)p)); }
__device__ __forceinline__ float bf2f(unsigned short h) { return __uint_as_float((unsigned)h << 16); }
__device__ __forceinline__ float row_rstd(const float* SS, int r) {
    const f32x4* p = (const f32x4*)(SS + (size_t)r * 16);
    const f32x4 a = p[0], b = p[1], c = p[2], d = p[3]; const f32x4 s = (a + b) + (c + d);
    return __builtin_amdgcn_rsqf(((s.x + s.y) + (s.z + s.w)) * (1.0f / DM) + EPS);
}
__device__ __forceinline__ float silu_mul(float g, float u) { return g * __builtin_amdgcn_rcpf(1.0f + __builtin_amdgcn_exp2f(-1.4426950408889634f * g)) * u; }

struct Args {
    const float* in[22]; float* out; unsigned char* ws; float invf[8]; int ph_lo, ph_hi;
};
typedef const __attribute__((address_space(4))) Args* KArgs;
__device__ __forceinline__ KArgs kargs_now() { KArgs ka = (KArgs)__builtin_amdgcn_kernarg_segment_ptr(); asm volatile("" : "+s"(ka)); return ka; }
struct EpiSwiGLU {
    static constexpr bool PERM = true, AFTER_DRAIN = false;
    const LAS float* rst;
    __device__ __forceinline__ void operator()(const f32x4 (&acc)[2][2][4][2], const pg8::Unit& u, int wr, int wc, int fr, int fq) const {
        const KArgs ka = kargs_now(); unsigned char* ws = ka->ws; bf16* O = (bf16*)(ws + WS_ACT); const LAS float* rt = rst + u.ui * 256 + wr * 64 + fr;
        const int row0 = u.pm * 256 + wr * 64 + fr, col0 = u.pn * 128 + wc * 32 + 8 * fq;
#pragma unroll
        for (int ai = 0; ai < 2; ++ai)
#pragma unroll
            for (int m = 0; m < 4; ++m) {
                const int r = row0 + ai * 128 + m * 16; const float rs = rt[ai * 128 + m * 16];
                const f32x4 g0 = acc[ai][0][m][0] * rs, g1 = acc[ai][0][m][1] * rs, u0 = acc[ai][1][m][0] * rs, u1 = acc[ai][1][m][1] * rs;
                v4u w; w.x = cvt_pk_bf16(silu_mul(g0[0], u0[0]), silu_mul(g0[1], u0[1])); w.y = cvt_pk_bf16(silu_mul(g0[2], u0[2]), silu_mul(g0[3], u0[3]));
                w.z = cvt_pk_bf16(silu_mul(g1[0], u1[0]), silu_mul(g1[1], u1[1])); w.w = cvt_pk_bf16(silu_mul(g1[2], u1[2]), silu_mul(g1[3], u1[3]));
                __builtin_nontemporal_store(w, (v4u*)(O + (size_t)(r >> 8) * (256 * DFF) + (size_t)(col0 >> 6) * (256 * 64) + (r & 255) * 64 + (col0 & 63)));
            }
    }
};
template <int MODE> struct EpiRes {
    static constexpr bool PERM = true, AFTER_DRAIN = false;
    __device__ __forceinline__ void operator()(const f32x4 (&acc)[2][2][4][2], const pg8::Unit& u, int wr, int wc, int fr, int fq) const {
        const KArgs ka = kargs_now(); unsigned char* ws = ka->ws; bf16* XB = (bf16*)(ws + WS_XB); float* SS = (float*)(ws + WS_SS); float* out = ka->out;
        constexpr float alpha = (MODE == 1) ? 1.0f : 0.5f;
        const int col0 = u.pn * 256 + wc * 32 + 8 * fq;
        v4u xin[2][4][2];
#pragma unroll
        for (int ai = 0; ai < 2; ++ai)
#pragma unroll
            for (int m = 0; m < 4; ++m) { const bf16* xrow = XB + (size_t)(u.pm * 256 + ai * 128 + wr * 64 + m * 16 + fr) * DM + col0;
#pragma unroll
                for (int bj = 0; bj < 2; ++bj) xin[ai][m][bj] = *(const v4u*)(xrow + bj * 128); }
#pragma unroll
        for (int ai = 0; ai < 2; ++ai)
#pragma unroll
            for (int m = 0; m < 4; ++m) {
                const int r = u.pm * 256 + ai * 128 + wr * 64 + m * 16 + fr;
                bf16* xrow = XB + (size_t)r * DM + col0; float* dst = out + O_Y + (size_t)r * DM + col0;
                float ss = 0.f;
#pragma unroll
                for (int bj = 0; bj < 2; ++bj) {
                    const v4u xi = xin[ai][m][bj]; f32x4 v0 = acc[ai][bj][m][0] * alpha, v1 = acc[ai][bj][m][1] * alpha;
                    v0[0] += __uint_as_float(xi.x << 16); v0[1] += __uint_as_float(xi.x & 0xffff0000u); v0[2] += __uint_as_float(xi.y << 16); v0[3] += __uint_as_float(xi.y & 0xffff0000u);
                    v1[0] += __uint_as_float(xi.z << 16); v1[1] += __uint_as_float(xi.z & 0xffff0000u); v1[2] += __uint_as_float(xi.w << 16); v1[3] += __uint_as_float(xi.w & 0xffff0000u);
                    if (MODE < 2) { v4u w; w.x = cvt_pk_bf16(v0[0], v0[1]); w.y = cvt_pk_bf16(v0[2], v0[3]); w.z = cvt_pk_bf16(v1[0], v1[1]); w.w = cvt_pk_bf16(v1[2], v1[3]); *(v4u*)(xrow + bj * 128) = w;
                        ss += ((v0[0] * v0[0] + v0[1] * v0[1]) + (v0[2] * v0[2] + v0[3] * v0[3])) + ((v1[0] * v1[0] + v1[1] * v1[1]) + (v1[2] * v1[2] + v1[3] * v1[3])); }
                    else { __builtin_nontemporal_store(v0, (f32x4*)(dst + bj * 128)); __builtin_nontemporal_store(v1, (f32x4*)(dst + bj * 128 + 4)); }
                }
                if (MODE < 2) { ss += __shfl_xor(ss, 16); ss += __shfl_xor(ss, 32); if (fq == 0) SS[(size_t)r * 16 + u.pn * 4 + wc] = ss; }
            }
    }
};
struct EpiIn {
    static constexpr bool PERM = true, AFTER_DRAIN = false;
    const LAS float* rst;
    __device__ __forceinline__ void operator()(const f32x4 (&acc)[2][2][4][2], const pg8::Unit& u, int wr, int wc, int fr, int fq) const {
        const KArgs ka = kargs_now(); unsigned char* ws = ka->ws; const LAS float* rt = rst + u.ui * 256 + wr * 64 + fr; bf16 *U = (bf16*)(ws + WS_U), *Q = (bf16*)(ws + WS_Q), *Kb = (bf16*)(ws + WS_K), *Vb = (bf16*)(ws + WS_V);
        const float* rope = (const float*)(ws + WS_ROPE); const float* qn = ka->in[12]; const float* kn = ka->in[13]; float* out = ka->out;
        const int row0 = u.pm * 256 + wr * 64 + fr;
        if (u.pn < 2) {
            const int col0 = u.pn * 256 + wc * 32 + 8 * fq;
#pragma unroll
            for (int ai = 0; ai < 2; ++ai)
#pragma unroll
                for (int m = 0; m < 4; ++m) {
                    const int r = row0 + ai * 128 + m * 16; const float rs = rt[ai * 128 + m * 16];
                    float* po = nullptr;
                    { const int b = r >> 11, t = (r & (SEQ - 1)) + NMETA; if (t >= TT - 15) po = out + O_PP + ((size_t)b * 15 + (t - (TT - 15))) * PW; }
#pragma unroll
                    for (int bj = 0; bj < 2; ++bj) {
                        const int c = col0 + bj * 128; const f32x4 v0 = acc[ai][bj][m][0] * rs, v1 = acc[ai][bj][m][1] * rs;
                        v4u w; w.x = cvt_pk_bf16(v0[0], v0[1]); w.y = cvt_pk_bf16(v0[2], v0[3]); w.z = cvt_pk_bf16(v1[0], v1[1]); w.w = cvt_pk_bf16(v1[2], v1[3]);
                        *(v4u*)(U + (size_t)r * PW + c) = w;
                        if (po) { *(f32x4*)(po + c) = v0; *(f32x4*)(po + c + 4) = v1; }
                    }
                }
        } else {
            int kind, hcol, ld; bf16* dst; const float* gain; size_t oprompt;
            if (u.pn < 4) { kind = 0; hcol = 64 * (4 * (u.pn - 2) + wc); ld = PW; dst = Q; gain = qn; oprompt = 0; }
            else if (wc < 2) { kind = 1; hcol = 64 * wc; ld = KVW; dst = Kb; gain = kn; oprompt = O_KP; }
            else { kind = 2; hcol = 64 * (wc - 2); ld = KVW; dst = Vb; gain = kn; oprompt = O_VP; }
            const int d0[2] = {fq == 0 ? 0 : 16 + 8 * (fq - 1), fq == 0 ? 8 : 40 + 8 * (fq - 1)};
            f32x4 gv[2][2];
#pragma unroll
            for (int bj = 0; bj < 2; ++bj)
#pragma unroll
                for (int n = 0; n < 2; ++n) gv[bj][n] = *(const f32x4*)(gain + d0[bj] + 4 * n);
            const bool rot = (kind < 2) && (fq == 0);
            f32x4 rcs[8][2], rsn[8][2];
            if (rot) { const float* rp = rope + (size_t)((row0 & (SEQ - 1)) + NMETA) * 16;
#pragma unroll
                for (int n = 0; n < 2; ++n) { rcs[0][n] = *(const f32x4*)(rp + 4 * n); rsn[0][n] = *(const f32x4*)(rp + 8 + 4 * n); } }
#pragma unroll
            for (int ai = 0; ai < 2; ++ai) {
#pragma unroll
                for (int m = 0; m < 4; ++m) {
                    if (rot && (ai * 4 + m) < 7) { const int r1 = row0 + ((ai * 4 + m + 1) >> 2) * 128 + ((ai * 4 + m + 1) & 3) * 16; const float* rp = rope + (size_t)((r1 & (SEQ - 1)) + NMETA) * 16;
#pragma unroll
                        for (int n = 0; n < 2; ++n) { rcs[ai * 4 + m + 1][n] = *(const f32x4*)(rp + 4 * n); rsn[ai * 4 + m + 1][n] = *(const f32x4*)(rp + 8 + 4 * n); } }
                    const int r = row0 + ai * 128 + m * 16; const float rs = rt[ai * 128 + m * 16];
                    f32x4 z[2][2];
#pragma unroll
                    for (int bj = 0; bj < 2; ++bj)
#pragma unroll
                        for (int n = 0; n < 2; ++n) z[bj][n] = acc[ai][bj][m][n] * rs;
                    const int b = r >> 11, t = (r & (SEQ - 1)) + NMETA;
                    if (kind < 2) {
                        float ss = 0.f;
#pragma unroll
                        for (int bj = 0; bj < 2; ++bj)
#pragma unroll
                            for (int n = 0; n < 2; ++n) ss += (z[bj][n][0] * z[bj][n][0] + z[bj][n][1] * z[bj][n][1]) + (z[bj][n][2] * z[bj][n][2] + z[bj][n][3] * z[bj][n][3]);
                        ss += __shfl_xor(ss, 16); ss += __shfl_xor(ss, 32);
                        const float inv = __builtin_amdgcn_rsqf(ss * (1.0f / HD) + EPS);
#pragma unroll
                        for (int bj = 0; bj < 2; ++bj)
#pragma unroll
                            for (int n = 0; n < 2; ++n) z[bj][n] = z[bj][n] * inv * gv[bj][n];
                        if (fq == 0) {
#pragma unroll
                            for (int n = 0; n < 2; ++n) { const f32x4 cs = rcs[ai * 4 + m][n], sn = rsn[ai * 4 + m][n]; const f32x4 x1 = z[0][n], x2 = z[1][n]; z[0][n] = x1 * cs - x2 * sn; z[1][n] = x2 * cs + x1 * sn; }
                        }
                    }
                    float* po = nullptr;
                    if (kind > 0 && t >= TT - 128) po = out + oprompt + ((size_t)b * 128 + (t - (TT - 128))) * KVW + hcol;
#pragma unroll
                    for (int bj = 0; bj < 2; ++bj) {
                        v4u w; w.x = cvt_pk_bf16(z[bj][0][0], z[bj][0][1]); w.y = cvt_pk_bf16(z[bj][0][2], z[bj][0][3]); w.z = cvt_pk_bf16(z[bj][1][0], z[bj][1][1]); w.w = cvt_pk_bf16(z[bj][1][2], z[bj][1][3]);
                        *(v4u*)(dst + (size_t)r * ld + hcol + d0[bj]) = w;
                        if (po) { *(f32x4*)(po + d0[bj]) = z[bj][0]; *(f32x4*)(po + d0[bj] + 4) = z[bj][1]; }
                    }
                }
            }
        }
    }
};

__device__ __forceinline__ float wave_sum(float v) {
#pragma unroll
    for (int o = 1; o < 64; o <<= 1) v += __shfl_xor(v, o);
    return v;
}
template <bool HG, bool TILED = false>
__device__ __forceinline__ void transpose_item(const float* W, int N, const float* gain, bf16* WT, int ldt, int nrow0, int k0, int sc, LAS float* scr, int lane) {
#pragma unroll
    for (int i = 0; i < 32; ++i) { const int kk = 2 * i + (lane >> 5); float v = __builtin_nontemporal_load(W + (size_t)(k0 + kk) * N + sc); if (HG) v *= gain[k0 + kk]; scr[kk * 33 + (lane & 31)] = v; }
    LDS_WAIT(); asm volatile("" ::: "memory");
    const int c = lane & 7;
#pragma unroll
    for (int j = 0; j < 4; ++j) { const int n = (lane >> 3) + 8 * j; const LAS float* s = scr + (8 * c) * 33 + n;
        v4u o; o.x = cvt_pk_bf16(s[0 * 33], s[1 * 33]); o.y = cvt_pk_bf16(s[2 * 33], s[3 * 33]); o.z = cvt_pk_bf16(s[4 * 33], s[5 * 33]); o.w = cvt_pk_bf16(s[6 * 33], s[7 * 33]);
        if (TILED) *(v4u*)(WT + (size_t)((nrow0 + n) >> 8) * (256 * (size_t)ldt) + (size_t)(k0 >> 6) * (256 * 64) + ((nrow0 + n) & 255) * 64 + 8 * c) = o;
        else *(v4u*)(WT + (size_t)(nrow0 + n) * ldt + k0 + 8 * c) = o; }
    LDS_WAIT(); asm volatile("" ::: "memory");
}
__device__ __forceinline__ int win_src(int np) {
    const int pn = np >> 8; if (pn < 2) return np;
    const int bj = (np >> 7) & 1, wc = (np >> 5) & 3, j = np & 31, dm = (j < 8) ? 8 * bj + j : 16 + 24 * bj + (j - 8);
    if (pn < 4) return 512 + 64 * (4 * (pn - 2) + wc) + dm;
    return (wc < 2) ? 1024 + 64 * wc + dm : 1152 + 64 * (wc - 2) + dm;
}
__device__ __forceinline__ int win_row(int pn, int wc, int d) {
    const int bj = (d < 8) ? 0 : (d < 16) ? 1 : (d < 40) ? 0 : 1, j = (d < 8) ? d : (d < 16) ? d - 8 : (d < 40) ? d - 8 : d - 32;
    return 256 * pn + 128 * bj + 32 * wc + j;
}

constexpr int SLAB_P = 33, SLAB_F = NTAIL * SLAB_P, SLAB_B = SLAB_F * 4;
constexpr int T_SLABS = 0, T_R0 = 4 * SLAB_B, T_R1 = 5 * SLAB_B, T_RS = 6 * SLAB_B;
static_assert(T_RS + NTAIL * 4 <= RING_BYTES, "tail LDS");
template <int K, int MT = 9, bool BT = false>
__device__ __forceinline__ void skinny_pass(const bf16* A, const bf16* bp0, const bf16* bp1, LAS unsigned char* lds, int roff, int tid, int wave, int lane, int m0 = 0) {
    constexpr int KW = K / 8, NS = KW / 32;
    const int c = lane & 15, g = lane >> 4;
    const bf16* ap = A + (size_t)(16 * m0 + c) * K + wave * KW + 8 * g;     const int kb0 = wave * KW + 8 * g; const bf16* b0 = BT ? bp0 : bp0 + kb0; const bf16* b1 = BT ? bp1 : bp1 + kb0;
#define SK_BOFF(kx) (BT ? ((((kb0 + 32 * (kx)) >> 6) << 14) + ((kb0 + 32 * (kx)) & 63)) : 32 * (kx))
    f32x4 acc[MT][2];
#pragma unroll
    for (int m = 0; m < MT; ++m) { acc[m][0] = (f32x4){0.f, 0.f, 0.f, 0.f}; acc[m][1] = (f32x4){0.f, 0.f, 0.f, 0.f}; }
    bf16x8 af[MT], bf0, bf1;
#pragma unroll
    for (int m = 0; m < MT; ++m) af[m] = *(const bf16x8*)(ap + (size_t)(16 * m) * K);
    bf0 = *(const bf16x8*)(b0 + SK_BOFF(0)); bf1 = *(const bf16x8*)(b1 + SK_BOFF(0));
#pragma unroll (MT <= 3 ? 4 : 1)
    for (int ks = 0; ks < NS; ++ks) {
        const int kn = (ks + 1 < NS) ? ks + 1 : ks;
        bf16x8 an[MT];
#pragma unroll
        for (int m = 0; m < MT; ++m) an[m] = *(const bf16x8*)(ap + (size_t)(16 * m) * K + 32 * kn);
        const bf16x8 bn0 = *(const bf16x8*)(b0 + SK_BOFF(kn)), bn1 = *(const bf16x8*)(b1 + SK_BOFF(kn));
#pragma unroll
        for (int m = 0; m < MT; ++m) { acc[m][0] = __builtin_amdgcn_mfma_f32_16x16x32_bf16(af[m], bf0, acc[m][0], 0, 0, 0); acc[m][1] = __builtin_amdgcn_mfma_f32_16x16x32_bf16(af[m], bf1, acc[m][1], 0, 0, 0); }
#pragma unroll
        for (int m = 0; m < MT; ++m) af[m] = an[m];
        bf0 = bn0; bf1 = bn1;
    }
    LAS float* sl = (LAS float*)(lds + T_SLABS) + (wave & 3) * SLAB_F + (4 * g) * SLAB_P + c;
    if (wave >= 4) {
#pragma unroll
        for (int m = 0; m < MT; ++m)
#pragma unroll
            for (int n = 0; n < 2; ++n)
#pragma unroll
                for (int e = 0; e < 4; ++e) sl[(16 * m + e) * SLAB_P + 16 * n] = acc[m][n][e];
    }
    __syncthreads();
    if (wave < 4) {
#pragma unroll
        for (int m = 0; m < MT; ++m)
#pragma unroll
            for (int n = 0; n < 2; ++n)
#pragma unroll
                for (int e = 0; e < 4; ++e) { const float v = acc[m][n][e] + sl[(16 * m + e) * SLAB_P + 16 * n]; sl[(16 * m + e) * SLAB_P + 16 * n] = v; }
    }
    __syncthreads();
    { const LAS float* s0 = (const LAS float*)(lds + T_SLABS); LAS float* R = (LAS float*)(lds + roff);
      for (int idx = tid; idx < 16 * MT * 32; idx += NTHR) { const int o = (idx >> 5) * SLAB_P + (idx & 31); R[o] = (s0[o] + s0[SLAB_F + o]) + (s0[2 * SLAB_F + o] + s0[3 * SLAB_F + o]); } }
    __syncthreads();
}
__device__ __forceinline__ void tail_rstd(const float* sst, LAS unsigned char* lds, int tid) {
    if (tid < NTAIL) { const f32x4* p = (const f32x4*)(sst + (size_t)tid * 32); f32x4 s = p[0];
#pragma unroll
        for (int i = 1; i < 8; ++i) s += p[i];
        ((LAS float*)(lds + T_RS))[tid] = __builtin_amdgcn_rsqf(((s.x + s.y) + (s.z + s.w)) * (1.0f / DM) + EPS); }
    __syncthreads();
}

constexpr int I_G = 16 * 88, I_IN = 16 * 40, I_OA = 8 * 32, I_OP = 1024, NITEMS = 6 * I_G + I_IN + I_OA + I_OP;
__device__ __forceinline__ void conv_item(int r, KArgs ka, LAS float* scr, int lane) {
    unsigned char* ws = ka->ws;
    bf16 *W1GU = (bf16*)(ws + WS_W1GU), *W1D = (bf16*)(ws + WS_W1D), *WIN = (bf16*)(ws + WS_WIN), *WOUT = (bf16*)(ws + WS_WOUT), *W2GU = (bf16*)(ws + WS_W2GU), *W2D = (bf16*)(ws + WS_W2D);
    if (r < 6 * I_G) {
        const int f = r / (3 * I_G); r -= f * 3 * I_G; const int which = r / I_G; r -= which * I_G;
        const float* gain = ka->in[f ? 18 : 6];
        if (which < 2) { const int kb = r / 88, nb = r % 88, n0 = 32 * nb; const float* W = ka->in[(f ? 19 : 7) + which];
            transpose_item<true>(W, DFF, gain, f ? W2GU : W1GU, DM, 256 * (n0 >> 7) + (n0 & 127) + 128 * which, 64 * kb, n0 + (lane & 31), scr, lane); }
        else { const int kb = r / 32, nb = r % 32; const float* W = ka->in[f ? 21 : 9];
            transpose_item<false, true>(W, DM, nullptr, f ? W2D : W1D, DFF, 32 * nb, 64 * kb, 32 * nb + (lane & 31), scr, lane); }
        return;
    }
    r -= 6 * I_G;
    if (r < I_IN) { const int kb = r / 40, nb = r % 40; transpose_item<true>(ka->in[11], NIN, ka->in[10], WIN, DM, 32 * nb, 64 * kb, win_src(32 * nb + (lane & 31)), scr, lane); return; }
    r -= I_IN;
    if (r < I_OA) { const int kb = r / 32, nb = r % 32; transpose_item<false>(ka->in[17] + (size_t)PW * DM, DM, nullptr, WOUT + PW, DM, 32 * nb, 64 * kb, 32 * nb + (lane & 31), scr, lane); return; }
    r -= I_OA;
    {
        const int g = r >> 8, ib = (r >> 4) & 15, nb = r & 15, n = 64 * nb + lane;
        const float* pw = ka->in[15] + ((size_t)g * 128 + 8 * ib) * 128; const float* psc = ka->in[16] + 128 * g; const float* wo = ka->in[17] + (size_t)(128 * g) * DM + n;
        float a[8];
#pragma unroll
        for (int ii = 0; ii < 8; ++ii) a[ii] = 0.f;
#pragma unroll 32
        for (int j = 0; j < 128; ++j) { const float wv = wo[(size_t)j * DM] * psc[j];
#pragma unroll
            for (int ii = 0; ii < 8; ++ii) a[ii] += pw[ii * 128 + j] * wv; }
        v4u o; o.x = cvt_pk_bf16(a[0], a[1]); o.y = cvt_pk_bf16(a[2], a[3]); o.z = cvt_pk_bf16(a[4], a[5]); o.w = cvt_pk_bf16(a[6], a[7]);
        *(v4u*)(WOUT + (size_t)n * DM + 128 * g + 8 * ib) = o;
    }
}

__global__ void __launch_bounds__(NTHR, 2) hymba_fwd(Args args) {
    extern __shared__ __attribute__((aligned(16))) unsigned char lds_raw[];
    LAS unsigned char* lds = (LAS unsigned char*)lds_raw;
    const int tid = threadIdx.x, lane = tid & 63, wave = __builtin_amdgcn_readfirstlane(tid >> 6);
    const int G = gridDim.x, bx = blockIdx.x, vcu = (G % 8 == 0) ? (bx % 8) * (G / 8) + bx / 8 : bx;
    unsigned char* ws = args.ws;
    const float *x_prompt = args.in[0], *x_sample = args.in[1], *state_pool = args.in[2], *cache_k = args.in[3], *cache_v = args.in[4], *meta = args.in[5];
    float* out = args.out;
    float* SS = (float*)(ws + WS_SS); float* SST = (float*)(ws + WS_SST); float* ROPE = (float*)(ws + WS_ROPE);
    bf16 *W1GU = (bf16*)(ws + WS_W1GU), *W1D = (bf16*)(ws + WS_W1D), *WIN = (bf16*)(ws + WS_WIN), *WOUT = (bf16*)(ws + WS_WOUT), *W2GU = (bf16*)(ws + WS_W2GU), *W2D = (bf16*)(ws + WS_W2D);
    bf16 *XB = (bf16*)(ws + WS_XB), *ACT = (bf16*)(ws + WS_ACT), *Ub = (bf16*)(ws + WS_U), *Qb = (bf16*)(ws + WS_Q), *Kb = (bf16*)(ws + WS_K), *Vb = (bf16*)(ws + WS_V), *MIX = (bf16*)(ws + WS_MIX);
    const int lo = args.ph_lo, hi = args.ph_hi;
#define IN(k) (lo <= (k) && (k) < hi)
#define SEAM(k) do { if (IN(k) && IN((k) + 1)) { xcd_barrier(xbar); } } while (0)
    volatile LAS unsigned* xst = (volatile LAS unsigned*)(lds + RING_BYTES + 256);
    if (tid == 0) { xst[0] = 0u; xst[1] = 0u; }
    __syncthreads();
    XcdBarrier xbar; xbar.bar = (unsigned*)(ws + WS_CTL) + 4096; xbar.x = 0; xbar.st = nullptr;
    if (hi - lo > 1) xbar = xcd_barrier_post((unsigned*)(ws + WS_CTL) + 4096, xst);
    if (hi > 64) cg::this_grid().sync();

    LAS float* RST = (LAS float*)(lds + RING_BYTES + 1024);
#define BUILD_RST(S_) do { const int nU_ = ((S_).nwg - (S_).c + (S_).G - 1) / (S_).G, ntab_ = nU_ * 256; \
        for (int base_ = 0; base_ < ntab_; base_ += 4 * NTHR) { f32x4 p_[4][4]; \
            _Pragma("unroll") for (int e_ = 0; e_ < 4; ++e_) { int idx_ = base_ + tid + NTHR * e_; idx_ = idx_ < ntab_ ? idx_ : ntab_ - 1; pg8::Unit uu_; (S_).next(idx_ >> 8, uu_); \
                const f32x4* q_ = (const f32x4*)(SS + ((size_t)uu_.pm * 256 + (idx_ & 255)) * 16); p_[e_][0] = q_[0]; p_[e_][1] = q_[1]; p_[e_][2] = q_[2]; p_[e_][3] = q_[3]; } \
            _Pragma("unroll") for (int e_ = 0; e_ < 4; ++e_) { const int idx_ = base_ + tid + NTHR * e_; const f32x4 s_ = (p_[e_][0] + p_[e_][1]) + (p_[e_][2] + p_[e_][3]); \
                if (idx_ < ntab_) RST[idx_] = __builtin_amdgcn_rsqf(((s_.x + s_.y) + (s_.z + s_.w)) * (1.0f / DM) + EPS); } } \
        __syncthreads(); } while (0)
#define TAIL_SWIGLU(WGU, sst) do { tail_rstd((sst), lds, tid); \
        for (int su = bx; su < DFF / 16; su += G) { const int n0 = 16 * su, gr = 256 * (n0 >> 7) + (n0 & 127) + (lane & 15); \
            skinny_pass<DM>(XB + (size_t)TAIL0 * DM, (WGU) + (size_t)gr * DM, (WGU) + (size_t)(gr + 128) * DM, lds, T_R0, tid, wave, lane); \
            const LAS float* R = (const LAS float*)(lds + T_R0); const LAS float* RS = (const LAS float*)(lds + T_RS); \
            for (int idx = tid; idx < NTAIL * 16; idx += NTHR) { const int row = idx >> 4, col = idx & 15; const float rs = RS[row]; \
                ACT[(size_t)(TAIL0 + row) * DFF + n0 + col] = (bf16)(cvt_pk_bf16(silu_mul(R[row * SLAB_P + col] * rs, R[row * SLAB_P + 16 + col] * rs), 0.f) & 0xffffu); } \
            __syncthreads(); } } while (0)
#define TAIL_RES(MODE, KK, Aten, WT, sst_out) do { \
        for (int su = bx; su < 3 * (DM / 32); su += G) { const int cb = su / 3, mg = su - 3 * cb, n0 = 32 * cb, m0 = 3 * mg;     \
            skinny_pass<KK, 3, (KK) == DFF>((Aten) + (size_t)TAIL0 * (KK), ((KK) == DFF) ? (WT) + (size_t)((n0 + (lane & 15)) >> 8) * (256 * (KK)) + ((n0 + (lane & 15)) & 255) * 64 : (WT) + (size_t)(n0 + (lane & 15)) * (KK), \
                ((KK) == DFF) ? (WT) + (size_t)((n0 + 16 + (lane & 15)) >> 8) * (256 * (KK)) + ((n0 + 16 + (lane & 15)) & 255) * 64 : (WT) + (size_t)(n0 + 16 + (lane & 15)) * (KK), lds, T_R0, tid, wave, lane, m0); \
            const LAS float* R = (const LAS float*)(lds + T_R0); \
            for (int idx = tid; idx < 48 * 32; idx += NTHR) { const int rrel = idx >> 5, row = 16 * m0 + rrel, col = idx & 31; const size_t xo = (size_t)(TAIL0 + row) * DM + n0 + col; \
                const float v = bf2f(XB[xo]) + (((MODE) == 1) ? 1.0f : 0.5f) * R[rrel * SLAB_P + col]; \
                if ((MODE) < 2) { XB[xo] = (bf16)(cvt_pk_bf16(v, 0.f) & 0xffffu); float ss = v * v; ss += __shfl_xor(ss, 1); ss += __shfl_xor(ss, 2); ss += __shfl_xor(ss, 4); ss += __shfl_xor(ss, 8); ss += __shfl_xor(ss, 16); \
                    if (col == 0) (sst_out)[(size_t)row * 32 + cb] = ss; } \
                else if (row >= NMETA) out[O_YS + (size_t)(row - NMETA) * DM + n0 + col] = v; } \
            __syncthreads(); } } while (0)

    if (IN(0)) {
        LAS float* scr = (LAS float*)(lds + wave * 16384);
        const int gw = vcu * NWAVES + wave, NGW = G * NWAVES;
        { const KArgs ka = (KArgs)__builtin_amdgcn_kernarg_segment_ptr();
          for (int it = gw; it < 3 * I_G + I_IN; it += NGW) conv_item(it < 3 * I_G ? it : it + 3 * I_G, ka, scr, lane); }
        for (int r4 = gw; r4 < (MAIN + NTAIL) / 4; r4 += NGW) {
            f32x4 v[4][4];
#pragma unroll
            for (int rr = 0; rr < 4; ++rr) { const int r = 4 * r4 + rr; const float* src = (r < MAIN) ? x_prompt + (size_t)r * DM : (r < MAIN + NMETA) ? meta + (size_t)(r - MAIN) * DM : x_sample + (size_t)(r - MAIN - NMETA) * DM;
#pragma unroll
                for (int j = 0; j < 4; ++j) v[rr][j] = __builtin_nontemporal_load((const f32x4*)src + lane + 64 * j); }
#pragma unroll
            for (int rr = 0; rr < 4; ++rr) { const int r = 4 * r4 + rr; float s = 0.f;
#pragma unroll
                for (int j = 0; j < 4; ++j) s += (v[rr][j].x * v[rr][j].x + v[rr][j].y * v[rr][j].y) + (v[rr][j].z * v[rr][j].z + v[rr][j].w * v[rr][j].w);
                s = wave_sum(s);
#pragma unroll
                for (int j = 0; j < 4; ++j) { v2u w; w.x = cvt_pk_bf16(v[rr][j].x, v[rr][j].y); w.y = cvt_pk_bf16(v[rr][j].z, v[rr][j].w); ((v2u*)(XB + (size_t)r * DM))[lane + 64 * j] = w; }
                if (r < MAIN) { if (lane < 16) SS[(size_t)r * 16 + lane] = (lane == 0) ? s : 0.f; } else if (lane < 32) SST[(size_t)(r - MAIN) * 32 + lane] = (lane == 0) ? s : 0.f; }
        }
        const int gt = vcu * NTHR + tid, NGT = G * NTHR;
        for (int i = gt; i < NPOS * 8; i += NGT) {
            const int p = i >> 3, f = i & 7; const float pos = (p < TT) ? (float)p : (float)PASTLEN; const float ang = pos * args.invf[f];
            const double xd = (double)ang, nn = __builtin_rint(xd * 0.15915494309189535), rr = __builtin_fma(-nn, 6.283185307179586, xd), r2 = rr * rr;
            double c = 1.0, s = rr, tc = 1.0, ts = rr;
#pragma unroll
            for (int k = 1; k <= 15; ++k) { tc *= -r2 * (1.0 / (double)((2 * k - 1) * (2 * k))); c += tc; ts *= -r2 * (1.0 / (double)((2 * k) * (2 * k + 1))); s += ts; }
            ROPE[(size_t)p * 16 + f] = (float)c; ROPE[(size_t)p * 16 + 8 + f] = (float)s;
        }
    }
    SEAM(0);
    if (IN(1)) { TAIL_SWIGLU(W1GU, SST);
        { pg8::Gemm g{XB, W1GU, MAIN, NGU, DM}; pg8::StaticOrder S; S.init(MAIN, NGU, G, bx); BUILD_RST(S); EpiSwiGLU E{RST};
        pg8::gemm_phase<EpiSwiGLU, pg8::StaticOrder, true, true, DM>(lds, g, S, E); }  }
    SEAM(1);
    if (IN(2)) { TAIL_RES(0, DFF, ACT, W1D, SST + NTAIL * 32);
        { pg8::Gemm g{ACT, W1D, MAIN, DM, DFF}; pg8::StaticOrder S; S.init(MAIN, DM, G, bx); EpiRes<0> E{};
        pg8::gemm_phase<EpiRes<0>, pg8::StaticOrder, true, true, DFF, true, true>(lds, g, S, E); }  }
    SEAM(2);
    if (IN(3)) {
        if (bx >= G / 2) {
            LAS float* scr = (LAS float*)(lds + wave * 16384); const int hw = (bx - G / 2) * NWAVES + wave, NHW = (G - G / 2) * NWAVES;
            const KArgs ka = (KArgs)__builtin_amdgcn_kernarg_segment_ptr();
            for (int it = hw; it < 3 * I_G + I_OA + I_OP; it += NHW) conv_item(it < 3 * I_G ? it + 3 * I_G : it + 3 * I_G + I_IN, ka, scr, lane);
            const int ht = (bx - G / 2) * NTHR + tid, NHT = (G - G / 2) * NTHR;
            for (int i = ht; i < DB * 14 * (PW / 4); i += NHT) { const int q = i / (14 * (PW / 4)), rem = i - q * (14 * (PW / 4)); ((f32x4*)(out + O_PS))[(size_t)q * 15 * (PW / 4) + rem] = ((const f32x4*)state_pool)[(size_t)q * 15 * (PW / 4) + (PW / 4) + rem]; }
            for (int i0 = ht; i0 < DB * 127 * (KVW / 4); i0 += 4 * NHT) { f32x4 kk[4], vv[4]; size_t dd[4];
#pragma unroll
                for (int u = 0; u < 4; ++u) { int i = i0 + u * NHT; i = i < DB * 127 * (KVW / 4) ? i : DB * 127 * (KVW / 4) - 1; const int q = i / (127 * (KVW / 4)), rem = i - q * (127 * (KVW / 4)); dd[u] = (size_t)q * 128 * (KVW / 4) + rem;
                    kk[u] = ((const f32x4*)cache_k)[dd[u] + (KVW / 4)]; vv[u] = ((const f32x4*)cache_v)[dd[u] + (KVW / 4)]; }
#pragma unroll
                for (int u = 0; u < 4; ++u) { ((f32x4*)(out + O_KS))[dd[u]] = kk[u]; ((f32x4*)(out + O_VS))[dd[u]] = vv[u]; } }
            __syncthreads();
        }
        tail_rstd(SST + NTAIL * 32, lds, tid);
        for (int s3 = (bx >= G / 2) ? bx - G / 2 : 60; s3 < 60; s3 += G / 2) { const int su = s3 / 3, m0 = 3 * (s3 - 3 * su);
            const int kind = (su < 8) ? 3 : (su < 16) ? 0 : (su < 18) ? 1 : 2;
            const int hh = (kind == 3) ? su : (kind == 0) ? su - 8 : (kind == 1) ? su - 16 : su - 18;
            const int pn = (kind == 3) ? (hh >> 2) : (kind == 0) ? 2 + (hh >> 2) : 4, wc = (kind == 3) ? 0 : (kind == 0) ? (hh & 3) : (kind == 1) ? hh : 2 + hh;
#pragma unroll
            for (int p = 0; p < 2; ++p) { const int d0 = 32 * p + (lane & 15);
                const int r0 = (kind == 3) ? 64 * hh + d0 : win_row(pn, wc, d0), r1 = (kind == 3) ? 64 * hh + d0 + 16 : win_row(pn, wc, d0 + 16);
                skinny_pass<DM, 3>(XB + (size_t)TAIL0 * DM, WIN + (size_t)r0 * DM, WIN + (size_t)r1 * DM, lds, p ? T_R1 : T_R0, tid, wave, lane, m0); }
            const LAS float* RS = (const LAS float*)(lds + T_RS); const int d = lane; const LAS float* R = (const LAS float*)(lds + ((d < 32) ? T_R0 : T_R1)) + (d & 31);
            const float gain = (kind == 0) ? args.in[12][d] : (kind == 1) ? args.in[13][d] : 1.0f;
            for (int rrel = wave; rrel < 48; rrel += NWAVES) { const int row = 16 * m0 + rrel;
                float v = R[rrel * SLAB_P] * RS[row]; const size_t tr = (size_t)TAIL0 + row;
                if (kind == 3) { Ub[tr * PW + 64 * hh + d] = (bf16)(cvt_pk_bf16(v, 0.f) & 0xffffu); if (row >= NMETA) out[O_PS + ((size_t)(row - NMETA) * 15 + 14) * PW + 64 * hh + d] = v; }
                else {
                    if (kind < 2) { const float ssq = wave_sum(v * v); v = v * __builtin_amdgcn_rsqf(ssq * (1.0f / HD) + EPS) * gain;
                        const float pr = __shfl_xor(v, 8); const float* rp = ROPE + (size_t)((row < NMETA) ? row : TT) * 16 + (d & 7); const float cs = rp[0], sn = rp[8];
                        if (d < 8) v = v * cs - pr * sn; else if (d < 16) v = v * cs + pr * sn; }
                    if (kind == 0) Qb[tr * PW + 64 * hh + d] = (bf16)(cvt_pk_bf16(v, 0.f) & 0xffffu);
                    else { bf16* dstp = (kind == 1) ? Kb : Vb; dstp[tr * KVW + 64 * hh + d] = (bf16)(cvt_pk_bf16(v, 0.f) & 0xffffu);
                        if (row >= NMETA) out[((kind == 1) ? O_KS : O_VS) + ((size_t)(row - NMETA) * 128 + 127) * KVW + 64 * hh + d] = v; }
                }
            }
            __syncthreads();
        }
        { pg8::Gemm g{XB, WIN, MAIN, NIN, DM}; pg8::StaticOrder S; S.init(MAIN, NIN, G, bx); BUILD_RST(S); EpiIn E{RST};
        pg8::gemm_phase<EpiIn, pg8::StaticOrder, true, true, DM>(lds, g, S, E); } }
    SEAM(3);
    if (IN(4)) {
        constexpr int KPITCH = 144, KROWS = 192, KS_BYTES = 2 * KROWS * KPITCH, VS_OFF = KS_BYTES, PB_OFF = 2 * KS_BYTES;
        static_assert(PB_OFF <= RING_BYTES, "attention LDS");
        const float* sinks = args.in[14];
        constexpr int NPU = NB * 32;
        for (int ui0 = vcu; ui0 < NPU; ui0 += G) {
            const int ui = (G == 256) ? (((2 * (bx & 7) + (ui0 >> 8)) << 5) + (bx >> 3)) : ui0;
            const int b = ui >> 5, blk = ui & 31, t0 = 64 * blk + NMETA; const size_t rb = (size_t)b * SEQ;
            v4u kreg[6], vreg[6];
#pragma unroll
            for (int it = 0; it < 6; ++it) { const int ch = tid + it * NTHR, kk = ch >> 4, c16 = ch & 15; int p = t0 - 128 + kk; p = p < 0 ? 0 : p; const size_t row = (p >= NMETA) ? rb + (p - NMETA) : (size_t)TAIL0 + p;
                kreg[it] = *(const v4u*)(Kb + row * KVW + c16 * 8); vreg[it] = *(const v4u*)(Vb + row * KVW + c16 * 8); }
            unsigned xr[48];
            const int cp = tid & 255, rh = tid >> 8;
#pragma unroll
            for (int ii = 0; ii < 48; ++ii) { const int p = t0 + 32 * rh - 16 + ii; const size_t row = (p >= NMETA) ? rb + (p - NMETA) : (size_t)TAIL0 + p; xr[ii] = *(const unsigned*)(Ub + row * PW + 2 * cp); }
            const int h = wave, kvh = h >> 2, q = lane & 15, g = lane >> 4;
            bf16x8 qf[4][2];
#pragma unroll
            for (int j = 0; j < 4; ++j) { const bf16* qp = Qb + (rb + (t0 - NMETA) + 16 * j + q) * PW + 64 * h + 8 * g; qf[j][0] = *(const bf16x8*)(qp); qf[j][1] = *(const bf16x8*)(qp + 32); }
            { float xa[48], xb[48];
#pragma unroll
              for (int ii = 0; ii < 48; ++ii) { xa[ii] = __uint_as_float(xr[ii] << 16); xb[ii] = __uint_as_float(xr[ii] & 0xffff0000u); }
              bf16* mp = MIX + (rb + (t0 - NMETA) + 32 * rh) * DM + 2 * cp; const int wsel = cp >> 6;
#define POOL_W(W) { float Sa = 0.f, Sb = 0.f; _Pragma("unroll") for (int i = 16 - (W); i < 16; ++i) { Sa += xa[i]; Sb += xb[i]; } \
                _Pragma("unroll") for (int tt = 0; tt < 32; ++tt) { Sa += xa[16 + tt] - xa[16 + tt - (W)]; Sb += xb[16 + tt] - xb[16 + tt - (W)]; \
                    *(unsigned*)(mp + (size_t)tt * DM) = cvt_pk_bf16(Sa * (1.0f / (float)(W)) - xa[16 + tt], Sb * (1.0f / (float)(W)) - xb[16 + tt]); } }
              if (wsel == 0) POOL_W(2) else if (wsel == 1) POOL_W(4) else if (wsel == 2) POOL_W(8) else POOL_W(16)
#undef POOL_W
            }
#pragma unroll
            for (int it = 0; it < 6; ++it) { const int ch = tid + it * NTHR, kk = ch >> 4, c16 = ch & 15, kv = c16 >> 3, c8 = c16 & 7; const bool ok = (t0 - 128 + kk) >= 0;
                const v4u z4 = (v4u){0u, 0u, 0u, 0u}; const int off = (kv * KROWS + kk) * KPITCH + c8 * 16;
                *(LAS v4u*)(lds + off) = ok ? kreg[it] : z4; *(LAS v4u*)(lds + VS_OFF + off) = ok ? vreg[it] : z4; }
            __syncthreads();
            { const float sink = sinks[h] * 1.4426950408889634f;
              const LAS unsigned char* ksb = lds + (kvh * KROWS) * KPITCH; const LAS unsigned char* vsb = lds + VS_OFF + (kvh * KROWS) * KPITCH + (4 * g + ((lane >> 2) & 3)) * KPITCH + (lane & 3) * 8;
#pragma unroll
              for (int jp = 0; jp < 2; ++jp) {
                  f32x4 s[2][9]; float mx[2], l[2], rden[2];
#pragma unroll
                  for (int kt = 0; kt < 9; ++kt)
#pragma unroll
                      for (int jj = 0; jj < 2; ++jj) { const int j = 2 * jp + jj; const LAS unsigned char* kp = ksb + (16 * (j + kt) + q) * KPITCH + 16 * g;
                          const bf16x8 k0 = *(const LAS bf16x8*)(kp), k1 = *(const LAS bf16x8*)(kp + 64);
                          f32x4 a = (f32x4){0.f, 0.f, 0.f, 0.f}; a = __builtin_amdgcn_mfma_f32_16x16x32_bf16(k0, qf[j][0], a, 0, 0, 0); a = __builtin_amdgcn_mfma_f32_16x16x32_bf16(k1, qf[j][1], a, 0, 0, 0); s[jj][kt] = a; }
#pragma unroll
                  for (int jj = 0; jj < 2; ++jj) { const int tq0 = t0 + 16 * (2 * jp + jj), qpos = tq0 + q; float mxx = -1e30f;
#pragma unroll
                      for (int kt = 0; kt < 9; ++kt)
#pragma unroll
                          for (int e = 0; e < 4; ++e) { const int kp = tq0 - 128 + 16 * kt + 4 * g + e; const bool ok = (kp >= 0) && (kp <= qpos) && (kp > qpos - 128); const float v = ok ? s[jj][kt][e] * (0.125f * 1.4426950408889634f) : -1e30f; s[jj][kt][e] = v; mxx = fmaxf(mxx, v); }
                      mx[jj] = mxx; }
#pragma unroll
                  for (int jj = 0; jj < 2; ++jj) mx[jj] = fmaxf(mx[jj], __shfl_xor(mx[jj], 16));
#pragma unroll
                  for (int jj = 0; jj < 2; ++jj) mx[jj] = fmaxf(fmaxf(mx[jj], __shfl_xor(mx[jj], 32)), sink);
#pragma unroll
                  for (int jj = 0; jj < 2; ++jj) { float ll = 0.f;
#pragma unroll
                      for (int kt = 0; kt < 9; ++kt)
#pragma unroll
                          for (int e = 0; e < 4; ++e) { const float p = __builtin_amdgcn_exp2f(s[jj][kt][e] - mx[jj]); s[jj][kt][e] = p; ll += p; }
                      l[jj] = ll; }
#pragma unroll
                  for (int jj = 0; jj < 2; ++jj) l[jj] += __shfl_xor(l[jj], 16);
#pragma unroll
                  for (int jj = 0; jj < 2; ++jj) { l[jj] += __shfl_xor(l[jj], 32); rden[jj] = __builtin_amdgcn_rcpf(l[jj] + __builtin_amdgcn_exp2f(sink - mx[jj])); }
                  f32x4 o[2][4];
#pragma unroll
                  for (int jj = 0; jj < 2; ++jj)
#pragma unroll
                      for (int dt = 0; dt < 4; ++dt) o[jj][dt] = (f32x4){0.f, 0.f, 0.f, 0.f};
#pragma unroll
                  for (int s2 = 0; s2 < 5; ++s2)
#pragma unroll
                      for (int jj = 0; jj < 2; ++jj) { const int j = 2 * jp + jj;
                          v4u pw; pw.x = cvt_pk_bf16(s[jj][2 * s2][0], s[jj][2 * s2][1]); pw.y = cvt_pk_bf16(s[jj][2 * s2][2], s[jj][2 * s2][3]);
                          if (s2 < 4) { pw.z = cvt_pk_bf16(s[jj][2 * s2 + 1][0], s[jj][2 * s2 + 1][1]); pw.w = cvt_pk_bf16(s[jj][2 * s2 + 1][2], s[jj][2 * s2 + 1][3]); } else { pw.z = 0u; pw.w = 0u; }
                          const bf16x8 pf = __builtin_bit_cast(bf16x8, pw);
#pragma unroll
                          for (int dt = 0; dt < 4; ++dt) { const LAS unsigned char* vp = vsb + (16 * (j + 2 * s2)) * KPITCH + dt * 32;
                              const s16x4 va = vtr(vp), vb = vtr(vp + ((s2 < 4) ? 16 * KPITCH : 0)); const bf16x8 vf = (bf16x8){va[0], va[1], va[2], va[3], vb[0], vb[1], vb[2], vb[3]};
                              o[jj][dt] = __builtin_amdgcn_mfma_f32_16x16x32_bf16(vf, pf, o[jj][dt], 0, 0, 0); } }
#pragma unroll
                  for (int jj = 0; jj < 2; ++jj) { bf16* op = MIX + (rb + (t0 + 16 * (2 * jp + jj) - NMETA) + q) * DM + PW + 64 * h + 4 * g;
#pragma unroll
                      for (int dt = 0; dt < 4; ++dt) { v2u w; w.x = cvt_pk_bf16(o[jj][dt][0] * rden[jj], o[jj][dt][1] * rden[jj]); w.y = cvt_pk_bf16(o[jj][dt][2] * rden[jj], o[jj][dt][3] * rden[jj]); *(v2u*)(op + 16 * dt) = w; } }
              } }
            __syncthreads();
        }
        for (int su = vcu; su < 2 * DB; su += G) {
            const int i = su >> 1, kv = su & 1; const size_t r = (size_t)TAIL0 + NMETA + i;
            f32x4 kr4[4], vr4[4];
#pragma unroll
            for (int it = 0; it < 4; ++it) { int ch = tid + it * NTHR; ch = ch < 2032 ? ch : 2031; const int row = ch >> 4, c = ch & 15; const size_t off = ((size_t)i * 128 + row + 1) * KVW + 64 * kv + 4 * c;
                kr4[it] = *(const f32x4*)(cache_k + off); vr4[it] = *(const f32x4*)(cache_v + off); }
            v4u knew = (v4u){0u, 0u, 0u, 0u}, vnew = (v4u){0u, 0u, 0u, 0u};
            if (tid < 8) { knew = *(const v4u*)(Kb + r * KVW + 64 * kv + 8 * tid); vnew = *(const v4u*)(Vb + r * KVW + 64 * kv + 8 * tid); }
            if (kv == 0) {
                const int c = tid, w = 2 << (c >> 7); const float cur = bf2f(Ub[r * PW + c]); const float* sp = state_pool + (size_t)i * 15 * PW + c; float xs[15];
#pragma unroll
                for (int k = 0; k < 15; ++k) xs[k] = sp[(size_t)k * PW];
                float S = cur;
#pragma unroll
                for (int k = 0; k < 15; ++k) S += (k >= 16 - w) ? xs[k] : 0.f;
                const float d = S / (float)w - cur; MIX[r * DM + c] = (bf16)(cvt_pk_bf16(d, 0.f) & 0xffffu);
            }
#pragma unroll
            for (int it = 0; it < 4; ++it) { const int ch = tid + it * NTHR; if (ch < 2032) { const int row = ch >> 4, c = ch & 15, off = row * KPITCH + c * 8;
                v2u a; a.x = cvt_pk_bf16(kr4[it].x, kr4[it].y); a.y = cvt_pk_bf16(kr4[it].z, kr4[it].w); *(LAS v2u*)(lds + off) = a;
                v2u bq; bq.x = cvt_pk_bf16(vr4[it].x, vr4[it].y); bq.y = cvt_pk_bf16(vr4[it].z, vr4[it].w); *(LAS v2u*)(lds + VS_OFF + off) = bq; } }
            if (tid < 8) { *(LAS v4u*)(lds + 127 * KPITCH + tid * 16) = knew; *(LAS v4u*)(lds + VS_OFF + 127 * KPITCH + tid * 16) = vnew; }
            __syncthreads();
            if (wave == 0) {
                const int q = lane & 15, g = lane >> 4, hq = 4 * kv + (q & 3); const float sink = sinks[hq] * 1.4426950408889634f;
                const bf16* qp = Qb + r * PW + 64 * hq + 8 * g; const bf16x8 qf0 = *(const bf16x8*)(qp), qf1 = *(const bf16x8*)(qp + 32);
                const LAS unsigned char* vsb = lds + VS_OFF + (4 * g + ((lane >> 2) & 3)) * KPITCH + (lane & 3) * 8;
                f32x4 s[8]; float mx = -1e30f;
#pragma unroll
                for (int kt = 0; kt < 8; ++kt) { const LAS unsigned char* kp = lds + (16 * kt + q) * KPITCH + 16 * g;
                    const bf16x8 k0 = *(const LAS bf16x8*)(kp), k1 = *(const LAS bf16x8*)(kp + 64);
                    f32x4 a = (f32x4){0.f, 0.f, 0.f, 0.f}; a = __builtin_amdgcn_mfma_f32_16x16x32_bf16(k0, qf0, a, 0, 0, 0); a = __builtin_amdgcn_mfma_f32_16x16x32_bf16(k1, qf1, a, 0, 0, 0);
                    a = a * (0.125f * 1.4426950408889634f); s[kt] = a; mx = fmaxf(fmaxf(mx, fmaxf(a[0], a[1])), fmaxf(a[2], a[3])); }
                mx = fmaxf(mx, __shfl_xor(mx, 16)); mx = fmaxf(mx, __shfl_xor(mx, 32)); mx = fmaxf(mx, sink);
                float l = 0.f;
#pragma unroll
                for (int kt = 0; kt < 8; ++kt)
#pragma unroll
                    for (int e = 0; e < 4; ++e) { const float p = __builtin_amdgcn_exp2f(s[kt][e] - mx); s[kt][e] = p; l += p; }
                l += __shfl_xor(l, 16); l += __shfl_xor(l, 32);
                const float rden = __builtin_amdgcn_rcpf(l + __builtin_amdgcn_exp2f(sink - mx));
                f32x4 o[4];
#pragma unroll
                for (int dt = 0; dt < 4; ++dt) o[dt] = (f32x4){0.f, 0.f, 0.f, 0.f};
#pragma unroll
                for (int s2 = 0; s2 < 4; ++s2) {
                    v4u pw; pw.x = cvt_pk_bf16(s[2 * s2][0], s[2 * s2][1]); pw.y = cvt_pk_bf16(s[2 * s2][2], s[2 * s2][3]); pw.z = cvt_pk_bf16(s[2 * s2 + 1][0], s[2 * s2 + 1][1]); pw.w = cvt_pk_bf16(s[2 * s2 + 1][2], s[2 * s2 + 1][3]);
                    const bf16x8 pf = __builtin_bit_cast(bf16x8, pw);
#pragma unroll
                    for (int dt = 0; dt < 4; ++dt) { const LAS unsigned char* vp = vsb + (32 * s2) * KPITCH + dt * 32;
                        const s16x4 va = vtr(vp), vb = vtr(vp + 16 * KPITCH); const bf16x8 vf = (bf16x8){va[0], va[1], va[2], va[3], vb[0], vb[1], vb[2], vb[3]};
                        o[dt] = __builtin_amdgcn_mfma_f32_16x16x32_bf16(vf, pf, o[dt], 0, 0, 0); }
                }
                if (q < 4) { bf16* op = MIX + r * DM + PW + 64 * hq + 4 * g;
#pragma unroll
                    for (int dt = 0; dt < 4; ++dt) { v2u w; w.x = cvt_pk_bf16(o[dt][0] * rden, o[dt][1] * rden); w.y = cvt_pk_bf16(o[dt][2] * rden, o[dt][3] * rden); *(v2u*)(op + 16 * dt) = w; } }
            }
            __syncthreads();
        }
        for (int i = vcu * NTHR + tid; i < NMETA * (DM / 8); i += G * NTHR) ((v4u*)(MIX + (size_t)TAIL0 * DM))[i] = (v4u){0u, 0u, 0u, 0u};
    }
    SEAM(4);
    if (IN(5)) { TAIL_RES(1, DM, MIX, WOUT, SST + 2 * NTAIL * 32);
        { pg8::Gemm g{MIX, WOUT, MAIN, DM, DM}; pg8::StaticOrder S; S.init(MAIN, DM, G, bx); EpiRes<1> E{};
        pg8::gemm_phase<EpiRes<1>, pg8::StaticOrder, true, true, DM>(lds, g, S, E); }  }
    SEAM(5);
    if (IN(6)) { TAIL_SWIGLU(W2GU, SST + 2 * NTAIL * 32);
        { pg8::Gemm g{XB, W2GU, MAIN, NGU, DM}; pg8::StaticOrder S; S.init(MAIN, NGU, G, bx); BUILD_RST(S); EpiSwiGLU E{RST};
        pg8::gemm_phase<EpiSwiGLU, pg8::StaticOrder, true, true, DM>(lds, g, S, E); }  }
    SEAM(6);
    if (IN(7)) { TAIL_RES(2, DFF, ACT, W2D, SST);
        { pg8::Gemm g{ACT, W2D, MAIN, DM, DFF}; pg8::StaticOrder S; S.init(MAIN, DM, G, bx); EpiRes<2> E{};
        pg8::gemm_phase<EpiRes<2>, pg8::StaticOrder, true, true, DFF, true, true>(lds, g, S, E); }  }
#undef IN
#undef SEAM
}

extern "C" void kernel_launch(void* const* d_in, const int* in_sizes, int n_in, void* d_out, int out_size, void* d_ws, size_t ws_size, hipStream_t stream) {
    static int grid = 0;
    if (grid == 0) {
        if (n_in != 22 || (size_t)out_size != O_END || ws_size < WS_END) { fprintf(stderr, "kernel_launch: unexpected shapes: n_in %d out %d ws %zu (need %zu)\n", n_in, out_size, ws_size, (size_t)WS_END); grid = -1; return; }
        int dev = 0, cus = 0, per_cu = 0;
        if (hipGetDevice(&dev) != hipSuccess || hipDeviceGetAttribute(&cus, hipDeviceAttributeMultiprocessorCount, dev) != hipSuccess) { grid = -1; return; }
        if (hipFuncSetAttribute((const void*)hymba_fwd, hipFuncAttributeMaxDynamicSharedMemorySize, LDS_BYTES) != hipSuccess) { fprintf(stderr, "kernel_launch: hipFuncSetAttribute failed\n"); grid = -1; return; }
        if (hipOccupancyMaxActiveBlocksPerMultiprocessor(&per_cu, (const void*)hymba_fwd, NTHR, LDS_BYTES) != hipSuccess || per_cu < 1) { fprintf(stderr, "kernel_launch: occupancy query says %d\n", per_cu); per_cu = 1; }
        (void)hipGetLastError();
        grid = cus * 1;
    }
    if (grid < 0) return;
    if (hipMemsetAsync((char*)d_ws + WS_CTL, 0, 65536, stream) != hipSuccess) { fprintf(stderr, "kernel_launch: memset failed\n"); return; }
    Args a{};
    for (int i = 0; i < 22; ++i) a.in[i] = (const float*)d_in[i];
    a.out = (float*)d_out; a.ws = (unsigned char*)d_ws;
    for (int i = 0; i < 8; ++i) { const float e = (float)(-13.122363377404328) * (float)i * 0.125f; a.invf[i] = (float)std::exp((double)e); }
#if MK_N_LAUNCHES == 1
    a.ph_lo = 0; a.ph_hi = 8;
    void* kargs[] = {&a};
    const hipError_t e = hipLaunchCooperativeKernel((const void*)hymba_fwd, dim3(grid), dim3(NTHR), kargs, LDS_BYTES, stream);
    if (e != hipSuccess) fprintf(stderr, "kernel_launch: cooperative launch failed: %s (grid %d)\n", hipGetErrorString(e), grid);
#ifdef PROBE_PHASE
    a.ph_lo = PROBE_PHASE; a.ph_hi = PROBE_PHASE + 1; hipLaunchKernelGGL(hymba_fwd, dim3(grid), dim3(NTHR), LDS_BYTES, stream, a);
#endif
#else
    for (int p = 0; p < 8; ++p) { a.ph_lo = p; a.ph_hi = p + 1; hipLaunchKernelGGL(hymba_fwd, dim3(grid), dim3(NTHR), LDS_BYTES, stream, a); }
#endif
}
```
